# Optimizing an MI355X kernel written in HIP

```python
import math
import jax, jax.numpy as jnp
from jax import lax
import numpy as np

D_MODEL = 2048
BATCH = 2
SEQ = 4096
DEPTH = 1
DEC_BATCH = 128
DEC_SEQ = 4
PAST_LEN = 16384
PAGE_SIZE = 128

N_META = 16
WINDOW = 128
BLOCK = 128
A_HEADS = 16
A_KV_HEADS = 4
A_GROUP = A_HEADS // A_KV_HEADS
A_HEAD_DIM = 64
A_ROT_DIM = A_HEAD_DIM // 4
A_ROPE_THETA = 500000.0
A_WIDTH = A_HEADS * A_HEAD_DIM
A_KV_WIDTH = A_KV_HEADS * A_HEAD_DIM
R_HEADS = 8
R_KEY_DIM = 128
R_VAL_DIM = 256
R_QK_WIDTH = R_HEADS * R_KEY_DIM
R_V_WIDTH = R_HEADS * R_VAL_DIM
R_ROPE_THETA = 10000.0
R_CHUNK = 128
EPS = 1e-6
GN_EPS = 1e-5
NEG_INF = -1e30
SPLITS = (A_WIDTH, A_KV_WIDTH, A_KV_WIDTH, A_WIDTH, R_QK_WIDTH, R_QK_WIDTH, R_V_WIDTH, R_V_WIDTH, D_MODEL, D_MODEL)
SPLIT_POINTS = tuple(int(s) for s in np.cumsum(SPLITS)[:-1])
IN_WIDTH = sum(SPLITS)

kernel_name = "hybrid_swa_sink_retention_meta_step"


def rms_norm(x, g):
    xf = x.astype(jnp.float32)
    y = xf * lax.rsqrt(jnp.mean(xf * xf, axis=-1, keepdims=True) + EPS) * g.astype(jnp.float32)
    return y.astype(x.dtype)


def rope(x, pos, rot_dim, theta):
    half = rot_dim // 2
    inv = jnp.exp(-math.log(theta) * 2.0 * jnp.arange(half, dtype=jnp.float32) / rot_dim)
    ang = pos.astype(jnp.float32)[:, None] * inv[None, :]
    cos = jnp.cos(ang)[:, None, :]
    sin = jnp.sin(ang)[:, None, :]
    xf = x[..., :rot_dim].astype(jnp.float32)
    x1, x2 = xf[..., :half], xf[..., half:]
    rot = jnp.concatenate([x1 * cos - x2 * sin, x2 * cos + x1 * sin], axis=-1).astype(x.dtype)
    return jnp.concatenate([rot, x[..., rot_dim:]], axis=-1)


def layer_inputs(h, pos, norm_g, w_in, q_g, k_g):
    b, t = h.shape[0], h.shape[1]
    u = jnp.einsum('btd,de->bte', rms_norm(h, norm_g), w_in)
    qa, ka, va, za, qr, kr, vr, zr, ga, gr = jnp.split(u, SPLIT_POINTS, axis=-1)
    qa = rope(rms_norm(qa.reshape(b, t, A_HEADS, A_HEAD_DIM), q_g), pos, A_ROT_DIM, A_ROPE_THETA)
    qa = qa.reshape(b, t, A_KV_HEADS, A_GROUP, A_HEAD_DIM)
    ka = rope(rms_norm(ka.reshape(b, t, A_KV_HEADS, A_HEAD_DIM), k_g), pos, A_ROT_DIM, A_ROPE_THETA)
    va = va.reshape(b, t, A_KV_HEADS, A_HEAD_DIM)
    qr = rope(qr.reshape(b, t, R_HEADS, R_KEY_DIM), pos, R_KEY_DIM, R_ROPE_THETA).astype(jnp.float32)
    kr = (rope(kr.reshape(b, t, R_HEADS, R_KEY_DIM), pos, R_KEY_DIM, R_ROPE_THETA).astype(jnp.float32)
          * (R_KEY_DIM ** -0.5))
    vr = vr.reshape(b, t, R_HEADS, R_VAL_DIM).astype(jnp.float32)
    return (qa, ka, va), (qr, kr, vr), (za, zr, ga, gr)


def sink_attend(q, k, v, mask, sink):
    s = jnp.einsum('...qhgd,...khd->...hgqk', q, k).astype(jnp.float32) * (A_HEAD_DIM ** -0.5)
    s = jnp.where(mask, s, NEG_INF)
    sk = sink.astype(jnp.float32)[:, :, None, None]
    m = jnp.maximum(jnp.max(s, axis=-1, keepdims=True), sk)
    p = jnp.exp(s - m)
    p = p / (jnp.sum(p, axis=-1, keepdims=True) + jnp.exp(sk - m))
    o = jnp.einsum('...hgqk,...khd->...qhgd', p.astype(v.dtype), v)
    return o.reshape(o.shape[:-3] + (A_WIDTH,))


def retention_chunk(S, q, k, v, lg):
    S = S.astype(jnp.float32)
    c = q.shape[1]
    idx = jnp.arange(c, dtype=jnp.float32)
    rel = idx[:, None] - idx[None, :]
    decay = jnp.where(rel >= 0, jnp.exp(jnp.maximum(rel, 0.0)[None] * lg[:, None, None]), 0.0)
    inner = jnp.einsum('bihd,bjhd->bhij', q, k) * decay
    o = jnp.einsum('bhij,bjhe->bihe', inner, v)
    o = o + jnp.einsum('bihd,bhde->bihe', q, S) * jnp.exp((idx[:, None] + 1.0) * lg[None, :])[..., None]
    wk = jnp.exp((c - 1.0 - idx)[:, None] * lg[None, :])
    S_new = jnp.exp(c * lg)[:, None, None] * S + jnp.einsum('bjhd,bjhe->bhde', k * wk[..., None], v)
    return o, S_new


def retention_scan(S0, q, k, v, lg):
    b, t, h = q.shape[0], q.shape[1], q.shape[2]
    n = t // R_CHUNK

    def to_chunks(a):
        return a.reshape(b, n, R_CHUNK, h, a.shape[-1]).swapaxes(0, 1)

    def step(S, qkv):
        o, S = retention_chunk(S, qkv[0], qkv[1], qkv[2], lg)
        return S, o

    S, o = lax.scan(step, S0, (to_chunks(q), to_chunks(k), to_chunks(v)))
    return o.swapaxes(0, 1).reshape(b, t, h, R_VAL_DIM), S


def merge_out(o_a, o_r, gates, gn_g, gn_b, w_pa, w_pr, w_o):
    za, zr, ga, gr = gates
    mu = jnp.mean(o_r, axis=-1, keepdims=True)
    var = jnp.mean(jnp.square(o_r - mu), axis=-1, keepdims=True)
    o_r = ((o_r - mu) * lax.rsqrt(var + GN_EPS)).reshape(o_r.shape[:-2] + (R_V_WIDTH,))
    o_r = (o_r * gn_g.astype(jnp.float32) + gn_b.astype(jnp.float32)).astype(zr.dtype)
    y_a = (o_a * jax.nn.silu(za)) @ w_pa
    y_r = (o_r * jax.nn.silu(zr)) @ w_pr
    return (jax.nn.sigmoid(ga) * y_a + jax.nn.sigmoid(gr) * y_r) @ w_o


def setup_inputs(seed: int = 0) -> dict:
    key = jax.random.key(seed)
    ks = jax.random.split(key, 18)
    win_buf = min(WINDOW, PAST_LEN)
    f = jnp.float32
    nrm = jax.random.normal
    return {
        "x_prompt": nrm(ks[0], (BATCH, SEQ, D_MODEL), f),
        "x_sample": nrm(ks[1], (DEC_BATCH, DEC_SEQ, D_MODEL), f),
        "cache_win_k": nrm(ks[2], (DEPTH, DEC_BATCH, win_buf, A_KV_HEADS, A_HEAD_DIM), f),
        "cache_win_v": nrm(ks[3], (DEPTH, DEC_BATCH, win_buf, A_KV_HEADS, A_HEAD_DIM), f),
        "state_ret": 0.5 * nrm(ks[4], (DEPTH, DEC_BATCH, R_HEADS, R_KEY_DIM, R_VAL_DIM), f),
        "meta_tokens": nrm(ks[5], (N_META, D_MODEL), f),
        "norm_gain": 1.0 + 0.02 * nrm(ks[6], (DEPTH, D_MODEL), f),
        "w_in": nrm(ks[7], (DEPTH, D_MODEL, IN_WIDTH), f) * D_MODEL ** -0.5,
        "q_norm_gain": 1.0 + 0.02 * nrm(ks[8], (DEPTH, A_HEAD_DIM), f),
        "k_norm_gain": 1.0 + 0.02 * nrm(ks[9], (DEPTH, A_HEAD_DIM), f),
        "attn_sinks": 0.5 * nrm(ks[10], (DEPTH, A_HEADS), f),
        "ret_gn_gain": 1.0 + 0.02 * nrm(ks[11], (DEPTH, R_V_WIDTH), f),
        "ret_gn_bias": 0.02 * nrm(ks[12], (DEPTH, R_V_WIDTH), f),
        "w_branch_attn": nrm(ks[13], (DEPTH, A_WIDTH, D_MODEL), f) * A_WIDTH ** -0.5,
        "w_branch_ret": nrm(ks[14], (DEPTH, R_V_WIDTH, D_MODEL), f) * R_V_WIDTH ** -0.5,
        "w_out": nrm(ks[15], (DEPTH, D_MODEL, D_MODEL), f) * D_MODEL ** -0.5,
    }


def reference(x_prompt, x_sample, cache_win_k, cache_win_v, state_ret, meta_tokens, norm_gain, w_in,
              q_norm_gain, k_norm_gain, attn_sinks, ret_gn_gain, ret_gn_bias, w_branch_attn,
              w_branch_ret, w_out):
    lg = jnp.asarray(np.log(1.0 - np.exp(np.linspace(np.log(1.0 / 32), np.log(1.0 / 512), R_HEADS)))
                     .astype(np.float32))
    b_p, t_p = x_prompt.shape[0], x_prompt.shape[1]
    b_s, t_s = x_sample.shape[0], x_sample.shape[1]
    win_buf = cache_win_k.shape[2]
    nb = t_p // BLOCK

    pos_m = jnp.arange(N_META)
    pos_p = N_META + jnp.arange(t_p)
    pos_s = PAST_LEN + jnp.arange(t_s)

    mask_m = jnp.tril(jnp.ones((N_META, N_META), bool))
    qi = jnp.arange(BLOCK)[:, None]
    kj = jnp.arange(2 * BLOCK)[None, :] - BLOCK
    band = (kj <= qi) & (kj > qi - WINDOW)
    band = band[None] & ((jnp.arange(nb)[:, None, None] * BLOCK + kj[None]) >= 0)
    mask_p = jnp.concatenate([jnp.ones((nb, BLOCK, N_META), bool), band], axis=-1)[None, :, None, None]
    kpos = jnp.concatenate([PAST_LEN - win_buf + jnp.arange(win_buf), pos_s])
    band_s = ((kpos[None] <= pos_s[:, None]) & (kpos[None] > pos_s[:, None] - WINDOW)
              & (kpos[None] >= N_META))
    mask_s = jnp.concatenate([jnp.ones((t_s, N_META), bool), band_s], axis=-1)

    h_m = meta_tokens[None].astype(x_prompt.dtype)
    h_p = x_prompt
    h_s = x_sample
    wk_p, wv_p, rs_p, wk_s, wv_s, rs_s = [], [], [], [], [], []
    for l in range(DEPTH):
        sink = attn_sinks[l].reshape(A_KV_HEADS, A_GROUP)
        lw = (norm_gain[l], w_in[l], q_norm_gain[l], k_norm_gain[l])
        mw = (ret_gn_gain[l], ret_gn_bias[l], w_branch_attn[l], w_branch_ret[l], w_out[l])

        (qm, km, vm), (rqm, rkm, rvm), gm = layer_inputs(h_m, pos_m, *lw)
        o_am = sink_attend(qm, km, vm, mask_m, sink)
        o_rm, S_m = retention_chunk(jnp.zeros((1, R_HEADS, R_KEY_DIM, R_VAL_DIM), jnp.float32),
                                    rqm, rkm, rvm, lg)
        h_m_next = h_m + merge_out(o_am, o_rm, gm, *mw)

        (qp, kp, vp), (rqp, rkp, rvp), gp = layer_inputs(h_p, pos_p, *lw)
        qb = qp.reshape(b_p, nb, BLOCK, A_KV_HEADS, A_GROUP, A_HEAD_DIM)
        kb = kp.reshape(b_p, nb, BLOCK, A_KV_HEADS, A_HEAD_DIM)
        vb = vp.reshape(b_p, nb, BLOCK, A_KV_HEADS, A_HEAD_DIM)
        shp = (b_p, nb, N_META, A_KV_HEADS, A_HEAD_DIM)
        k_all = jnp.concatenate([jnp.broadcast_to(km[:, None], shp).astype(kb.dtype),
                                 jnp.concatenate([jnp.zeros_like(kb[:, :1]), kb[:, :-1]], axis=1), kb], axis=2)
        v_all = jnp.concatenate([jnp.broadcast_to(vm[:, None], shp).astype(vb.dtype),
                                 jnp.concatenate([jnp.zeros_like(vb[:, :1]), vb[:, :-1]], axis=1), vb], axis=2)
        o_ap = sink_attend(qb, k_all, v_all, mask_p, sink).reshape(b_p, t_p, A_WIDTH)
        S0 = jnp.broadcast_to(S_m, (b_p, R_HEADS, R_KEY_DIM, R_VAL_DIM))
        o_rp, S_p = retention_scan(S0, rqp, rkp, rvp, lg)
        h_p = h_p + merge_out(o_ap, o_rp, gp, *mw)
        wk_p.append(kp[:, -win_buf:])
        wv_p.append(vp[:, -win_buf:])
        rs_p.append(S_p)

        (qs, ks_, vs), (rqs, rks, rvs), gs = layer_inputs(h_s, pos_s, *lw)
        kw = jnp.concatenate([cache_win_k[l].astype(ks_.dtype), ks_], axis=1)
        vw = jnp.concatenate([cache_win_v[l].astype(vs.dtype), vs], axis=1)
        shs = (b_s, N_META, A_KV_HEADS, A_HEAD_DIM)
        k_all_s = jnp.concatenate([jnp.broadcast_to(km[0], shs).astype(kw.dtype), kw], axis=1)
        v_all_s = jnp.concatenate([jnp.broadcast_to(vm[0], shs).astype(vw.dtype), vw], axis=1)
        o_as = sink_attend(qs, k_all_s, v_all_s, mask_s, sink)
        o_rs, S_s = retention_chunk(state_ret[l], rqs, rks, rvs, lg)
        h_s = h_s + merge_out(o_as, o_rs, gs, *mw)
        wk_s.append(kw[:, -win_buf:])
        wv_s.append(vw[:, -win_buf:])
        rs_s.append(S_s)

        h_m = h_m_next

    win_k_prompt = jnp.stack(wk_p)
    win_v_prompt = jnp.stack(wv_p)
    ret_prompt = jnp.stack(rs_p)
    win_k_sample = jnp.stack(wk_s)
    win_v_sample = jnp.stack(wv_s)
    ret_sample = jnp.stack(rs_s)
    return (h_p, h_s, win_k_prompt, win_v_prompt, ret_prompt, win_k_sample, win_v_sample, ret_sample)
```

```cpp
#include <hip/hip_runtime.h>
#include <hip/hip_cooperative_groups.h>
#include <cstdio>
namespace cg = cooperative_groups;

#define LAS __attribute__((address_space(3)))
typedef unsigned short bf16_t;
typedef short bf16x8 __attribute__((ext_vector_type(8)));
typedef short bf16x4 __attribute__((ext_vector_type(4)));
typedef float f32x4 __attribute__((ext_vector_type(4)));
typedef float f32x2 __attribute__((ext_vector_type(2)));
typedef unsigned u32x4 __attribute__((ext_vector_type(4)));
typedef unsigned u32x2 __attribute__((ext_vector_type(2)));

constexpr int DM = 2048, NIN = 12800, MROWS = 8960, MR2 = 8704, TOKP = 8192, ROW_S = 8192, ROW_M = 8704;
constexpr int C_QA = 0, C_KA = 1024, C_VA = 1280, C_ZA = 1536, C_QR = 2560, C_KR = 3584, C_VR = 4608, C_ZR = 6656, C_GA = 8704, C_GR = 10752;
constexpr int UTP = 8960;
constexpr int UT_VA = 0, UT_KR = 256, UT_VR = 1280;
constexpr int TABP = 4128;
constexpr int KCAT = 3072;
constexpr size_t OFF_XN = 0, OFF_WINT = 36700160, OFF_ACAT = 0, OFF_MRG = 53477376;
constexpr size_t OFF_WCAT = 89128960, OFF_WO = OFF_WCAT + 12582912, OFF_U = OFF_WO + 8388608, OFF_UT = OFF_U + 229376000;
constexpr size_t OFF_UCT = OFF_UT + 59637760, OFF_SMT = OFF_UCT + 67108864, OFF_SPT = OFF_SMT + 1048576, OFF_TAB = OFF_SPT + 33554432;
constexpr size_t OFF_COSA = OFF_TAB, OFF_SINA = OFF_COSA + 132096, OFF_COSR = OFF_SINA + 132096, OFF_SINR = OFF_COSR + 1056768;
constexpr size_t OFF_COSRT = OFF_SINR + 1056768, OFF_SINRT = OFF_COSRT + 1056768, WS_END = OFF_SINRT + 1056768;
constexpr size_t O_YP = 0, O_YS = 16777216, O_WKP = 17825792, O_WVP = 17891328, O_RP = 17956864, O_WKS = 18481152, O_WVS = 22675456, O_RS = 26869760;
constexpr int LDS_BYTES = 160 * 1024;

struct Params {
    const float *x_prompt, *x_sample, *cache_k, *cache_v, *state, *meta, *norm_g, *w_in, *q_g, *k_g, *sinks, *gn_g, *gn_b, *w_pa, *w_pr, *w_o;
    float* out; unsigned char* ws; int ph_lo, ph_hi;
};

__device__ __forceinline__ unsigned cvt_pk_bf16(float lo, float hi) { unsigned r; asm("v_cvt_pk_bf16_f32 %0, %1, %2" : "=v"(r) : "v"(lo), "v"(hi)); return r; }
__device__ __forceinline__ bf16_t f2bf(float f) { return (bf16_t)(cvt_pk_bf16(f, 0.f) & 0xffffu); }
__device__ __forceinline__ float bf_lo(unsigned w) { return __uint_as_float(w << 16); }
__device__ __forceinline__ float bf_hi(unsigned w) { return __uint_as_float(w & 0xffff0000u); }
__device__ __forceinline__ float bf2f(bf16_t h) { return __uint_as_float(((unsigned)h) << 16); }
__device__ __forceinline__ float fast_exp(float x) { return __builtin_amdgcn_exp2f(x * 1.4426950408889634f); }
__device__ __forceinline__ float sigmoidf_(float x) { return __builtin_amdgcn_rcpf(1.0f + fast_exp(-x)); }
__device__ __forceinline__ float siluf_(float x) { return x * sigmoidf_(x); }
__device__ __forceinline__ float lg2_of(int h) {
    float r = -0.04580368961312479f;
    r = h == 1 ? -0.030662988889756927f : r; r = h == 2 ? -0.020562769581231145f : r; r = h == 3 ? -0.013805413024509017f : r;
    r = h == 4 ? -0.009275800472620728f : r; r = h == 5 ? -0.006235583073184706f : r; r = h == 6 ? -0.004193268921546044f : r;
    r = h == 7 ? -0.002820519062378663f : r; return r;
}
__device__ __forceinline__ void unpack8(u32x4 w, float* x) { x[0] = bf_lo(w.x); x[1] = bf_hi(w.x); x[2] = bf_lo(w.y); x[3] = bf_hi(w.y); x[4] = bf_lo(w.z); x[5] = bf_hi(w.z); x[6] = bf_lo(w.w); x[7] = bf_hi(w.w); }
__device__ __forceinline__ u32x4 pack8(const float* x) { u32x4 w; w.x = cvt_pk_bf16(x[0], x[1]); w.y = cvt_pk_bf16(x[2], x[3]); w.z = cvt_pk_bf16(x[4], x[5]); w.w = cvt_pk_bf16(x[6], x[7]); return w; }
__device__ __forceinline__ int pidx_of_row(int row) { return row < ROW_S ? 16 + (row & 4095) : (row < ROW_M ? 4112 + ((row - ROW_S) & 3) : row - ROW_M); }

namespace pg8 {
constexpr int BM = 256, BK = 64, HALF = 128, HTB = HALF * BK * 2, STAGE_BYTES = 8 * HTB, NXCD = 8, WGM = 8;
__device__ __forceinline__ int lds_byte(int r, int c) { const int st = (r >> 4) * 2 + (c >> 5), rr = r & 15, cc = c & 31, ob = rr * 64 + cc * 2; return st * 1024 + (ob ^ (((ob >> 9) & 1) << 5)); }
__device__ __forceinline__ void stage_rc(int b, int& R, int& C) { const int st = b / 1024, sb = b % 1024, swz = sb ^ (((sb >> 9) & 1) << 5); R = (st >> 1) * 16 + swz / 64; C = (st & 1) * 32 + (swz % 64) / 2; }
__device__ __forceinline__ int perm32(int rho) { const int n = rho >> 4, i = rho & 15; return 8 * (i >> 2) + 4 * n + (i & 3); }
struct Unit { int pm, pn; };
struct Gemm { const bf16_t* A; const bf16_t* Bt; int M, N, K; };
struct StaticOrder {
    int nM, nN, nwg, G, c;
    __device__ void init(int M, int N, int G_, int c_) { nM = M / BM; nN = N / BM; nwg = nM * nN; G = G_; c = c_; }
    __device__ bool next(int i, Unit& u) const {
        const long L = (long)i * G + c; if (L >= nwg) return false;
        int wgid = (int)L; { const int q = nwg / NXCD, r = nwg % NXCD, xcd = wgid % NXCD, off = wgid / NXCD; wgid = (xcd < r ? xcd * (q + 1) : r * (q + 1) + (xcd - r) * q) + off; }
        const int nig = WGM * nN, gid = wgid / nig, fm = gid * WGM, gsz = (nM - fm) < WGM ? (nM - fm) : WGM;
        u.pm = fm + ((wgid % nig) % gsz); u.pn = (wgid % nig) / gsz; return true;
    }
};

template <class Epi>
__device__ __forceinline__ void gemm_phase(LAS unsigned char* lds, const Gemm g, const StaticOrder& S, const Epi& E) {
    const int tid = threadIdx.x, wid = __builtin_amdgcn_readfirstlane(tid >> 6), lane = tid & 63, wr = wid >> 2, wc = wid & 3, fr = lane & 15, fq = lane >> 4;
    const int K = g.K, nt = K / BK;
    unsigned voffA[2], voffB[2];
#pragma unroll
    for (int i = 0; i < 2; ++i) { int R, C; stage_rc(tid * 16 + i * 8192, R, C); const int Rb = Epi::PERM ? ((R & ~31) + perm32(R & 31)) : R;
        voffA[i] = (unsigned)(R * K + C) * 2u; voffB[i] = (unsigned)(Rb * K + C) * 2u; }
    const size_t kstep = (size_t)(BK * 2);
    const size_t hstep = (size_t)HALF * K * 2;
    const size_t tstep = 2 * hstep;
    const unsigned ldsw = (unsigned)wid * 1024u;
    const int aoff = lds_byte(wr * 64 + fr, fq * 8), boff = lds_byte(wc * 32 + fr, fq * 8);
#define PG8_SA(b, h) (((b) * 2 + (h)) * HTB)
#define PG8_SB(b, h) ((4 + (b) * 2 + (h)) * HTB)
#define PG8_STAGE(bufoff, gbase, voff) do { _Pragma("unroll") for (int _i = 0; _i < 2; ++_i) \
        __builtin_amdgcn_global_load_lds((const unsigned*)((const char*)(gbase) + (voff)[_i]), (LAS unsigned*)(lds + (bufoff) + ldsw + _i * 8192), 16, 0, 0); } while (0)
#define PG8_LDA(dst, b, h) do { _Pragma("unroll") for (int m = 0; m < 4; ++m) _Pragma("unroll") for (int k = 0; k < 2; ++k) dst[m][k] = *(const LAS bf16x8*)(lds + PG8_SA(b, h) + aoff + m * 2048 + k * 1024); } while (0)
#define PG8_LDB(dst, b, h) do { _Pragma("unroll") for (int n = 0; n < 2; ++n) _Pragma("unroll") for (int k = 0; k < 2; ++k) dst[n][k] = *(const LAS bf16x8*)(lds + PG8_SB(b, h) + boff + n * 2048 + k * 1024); } while (0)
#define PG8_MMA(ai, bj, At, Bt) do { __builtin_amdgcn_s_setprio(1); _Pragma("unroll") for (int m = 0; m < 4; ++m) _Pragma("unroll") for (int n = 0; n < 2; ++n) _Pragma("unroll") for (int k = 0; k < 2; ++k) \
        acc[ai][bj][m][n] = __builtin_amdgcn_mfma_f32_16x16x32_bf16(Bt[n][k], At[m][k], acc[ai][bj][m][n], 0, 0, 0); __builtin_amdgcn_s_setprio(0); } while (0)
#define PG8_WAIT_V(n) asm volatile("s_waitcnt vmcnt(" #n ")" ::: "memory")
#define PG8_WAIT_L(n) asm volatile("s_waitcnt lgkmcnt(" #n ")" ::: "memory")
#define PG8_BAR __builtin_amdgcn_s_barrier()
#define PG8_SCHED __builtin_amdgcn_sched_barrier(0)
#define PG8_KBODY do { \
            const bool last = (t == nt - 2); \
            const char* a1 = cA + (size_t)(t + 1) * kstep; \
            const char* a2 = last ? nA : cA + (size_t)(t + 2) * kstep; const char* b2 = last ? nB : cB + (size_t)(t + 2) * kstep; \
            const char* a3 = a2 + kstep; const char* b3 = b2 + kstep; \
            PG8_LDB(B0, 0, 0); PG8_SCHED; PG8_LDA(At, 0, 0); PG8_STAGE(PG8_SA(1, 1), a1 + hstep, voffA); \
            PG8_WAIT_L(8); PG8_BAR; PG8_WAIT_L(0); PG8_MMA(0, 0, At, B0); PG8_BAR; PG8_SCHED; \
            PG8_LDB(B1, 0, 1); PG8_STAGE(PG8_SB(0, 0), b2, voffB); \
            PG8_BAR; PG8_WAIT_L(0); PG8_MMA(0, 1, At, B1); PG8_BAR; \
            PG8_LDA(At, 0, 1); PG8_STAGE(PG8_SA(0, 0), a2, voffA); \
            PG8_BAR; PG8_WAIT_L(0); PG8_MMA(1, 0, At, B0); PG8_BAR; PG8_SCHED; \
            PG8_STAGE(PG8_SB(0, 1), b2 + hstep, voffB); \
            PG8_WAIT_V(6); PG8_BAR; PG8_MMA(1, 1, At, B1); PG8_BAR; \
            PG8_LDB(B0, 1, 0); PG8_SCHED; PG8_LDA(At, 1, 0); PG8_STAGE(PG8_SA(0, 1), a2 + hstep, voffA); \
            PG8_WAIT_L(8); PG8_BAR; PG8_WAIT_L(0); PG8_MMA(0, 0, At, B0); PG8_BAR; PG8_SCHED; \
            PG8_LDB(B1, 1, 1); PG8_STAGE(PG8_SB(1, 0), b3, voffB); \
            PG8_BAR; PG8_WAIT_L(0); PG8_MMA(0, 1, At, B1); PG8_BAR; \
            PG8_LDA(At, 1, 1); PG8_STAGE(PG8_SA(1, 0), a3, voffA); \
            PG8_BAR; PG8_WAIT_L(0); PG8_MMA(1, 0, At, B0); PG8_BAR; PG8_SCHED; \
            PG8_STAGE(PG8_SB(1, 1), b3 + hstep, voffB); \
            PG8_WAIT_V(6); PG8_BAR; PG8_MMA(1, 1, At, B1); PG8_BAR; \
        } while (0)
    Unit cur, nxt; int ui = 0;
    if (!S.next(0, cur)) return;
    f32x4 acc[2][2][4][2];
#pragma unroll
    for (int a = 0; a < 2; ++a)
#pragma unroll
        for (int b = 0; b < 2; ++b)
#pragma unroll
            for (int m = 0; m < 4; ++m)
#pragma unroll
                for (int n = 0; n < 2; ++n) acc[a][b][m][n] = (f32x4){0.f, 0.f, 0.f, 0.f};
    bf16x8 At[4][2], B0[2][2], B1[2][2];
    const char* cA = (const char*)g.A + (size_t)cur.pm * tstep; const char* cB = (const char*)g.Bt + (size_t)cur.pn * tstep;
    PG8_STAGE(PG8_SB(0, 0), cB, voffB); PG8_STAGE(PG8_SA(0, 0), cA, voffA); PG8_STAGE(PG8_SB(0, 1), cB + hstep, voffB); PG8_STAGE(PG8_SA(0, 1), cA + hstep, voffA);
    if (wr == 1) PG8_BAR;
    PG8_WAIT_V(4); PG8_BAR;
    PG8_STAGE(PG8_SB(1, 0), cB + kstep, voffB); PG8_STAGE(PG8_SA(1, 0), cA + kstep, voffA); PG8_STAGE(PG8_SB(1, 1), cB + hstep + kstep, voffB);
    PG8_WAIT_V(6); PG8_BAR;
    for (;;) {
        const bool has_next = S.next(ui + 1, nxt);
        const char* nA = has_next ? (const char*)g.A + (size_t)nxt.pm * tstep : cA; const char* nB = has_next ? (const char*)g.Bt + (size_t)nxt.pn * tstep : cB;
        if constexpr (Epi::MID_T > 0) {
            for (int t = 0; t < Epi::MID_T; t += 2) PG8_KBODY;
            E.mid(acc, cur, wr, wc, fr, fq);
            for (int t = Epi::MID_T; t < nt; t += 2) PG8_KBODY;
        } else {
            for (int t = 0; t < nt; t += 2) PG8_KBODY;
        }
        E(acc, cur, wr, wc, fr, fq);
        if (!has_next) break;
#pragma unroll
        for (int a = 0; a < 2; ++a)
#pragma unroll
            for (int b = 0; b < 2; ++b)
#pragma unroll
                for (int m = 0; m < 4; ++m)
#pragma unroll
                    for (int n = 0; n < 2; ++n) acc[a][b][m][n] = (f32x4){0.f, 0.f, 0.f, 0.f};
        cur = nxt; cA = nA; cB = nB; ++ui;
    }
    PG8_WAIT_V(0);
    if (wr == 0) PG8_BAR;
    PG8_BAR;
#undef PG8_KBODY
#undef PG8_SA
#undef PG8_SB
#undef PG8_STAGE
#undef PG8_LDA
#undef PG8_LDB
#undef PG8_MMA
#undef PG8_WAIT_V
#undef PG8_WAIT_L
#undef PG8_BAR
#undef PG8_SCHED
}
}

struct EpiU {
    static constexpr bool PERM = true; static constexpr int MID_T = 0;
    bf16_t* U; bf16_t* UT;
    __device__ __forceinline__ void operator()(const f32x4 (&acc)[2][2][4][2], const pg8::Unit& u, int wr, int wc, int fr, int fq) const {
        const int row0 = u.pm * 256 + wr * 64 + fr, col0 = u.pn * 256 + wc * 32 + 8 * fq;
#pragma unroll
        for (int ai = 0; ai < 2; ++ai)
#pragma unroll
            for (int m = 0; m < 4; ++m) { bf16_t* rowp = U + (size_t)(row0 + ai * 128 + m * 16) * NIN + col0;
#pragma unroll
                for (int bj = 0; bj < 2; ++bj) { const f32x4 v0 = acc[ai][bj][m][0], v1 = acc[ai][bj][m][1];
                    u32x4 w; w.x = cvt_pk_bf16(v0[0], v0[1]); w.y = cvt_pk_bf16(v0[2], v0[3]); w.z = cvt_pk_bf16(v1[0], v1[1]); w.w = cvt_pk_bf16(v1[2], v1[3]);
                    *(u32x4*)(rowp + bj * 128) = w; } }
        int trow = -1;
        if (u.pn == 5) trow = UT_VA; else if (u.pn >= 14 && u.pn < 18) trow = UT_KR + (u.pn - 14) * 256; else if (u.pn >= 18 && u.pn < 26) trow = UT_VR + (u.pn - 18) * 256;
        if (trow >= 0) {
            bf16_t* base = UT + (size_t)(trow + wc * 32 + 8 * fq) * UTP + row0;
#pragma unroll
            for (int bj = 0; bj < 2; ++bj)
#pragma unroll
                for (int n = 0; n < 2; ++n)
#pragma unroll
                    for (int j = 0; j < 4; ++j) { bf16_t* cp = base + (size_t)(bj * 128 + 4 * n + j) * UTP;
#pragma unroll
                        for (int ai = 0; ai < 2; ++ai)
#pragma unroll
                            for (int m = 0; m < 4; ++m) cp[ai * 128 + m * 16] = f2bf(acc[ai][bj][m][n][j]); }
        }
    }
};
struct EpiMrg {
    static constexpr bool PERM = true; static constexpr int MID_T = 16;
    const bf16_t* U; bf16_t* O;
    __device__ __forceinline__ void mid(f32x4 (&acc)[2][2][4][2], const pg8::Unit& u, int wr, int wc, int fr, int fq) const {
        int row0 = u.pm * 256 + wr * 64 + fr; const int col0 = u.pn * 256 + wc * 32 + 8 * fq;
        asm volatile("" : "+v"(row0));
        const unsigned off0 = ((unsigned)row0 * NIN + col0) * 2u;
        const char* Ub = (const char*)U;
#pragma unroll
        for (int ai = 0; ai < 2; ++ai)
#pragma unroll
            for (int m = 0; m < 4; ++m) {
#pragma unroll
                for (int bj = 0; bj < 2; ++bj) { const unsigned off = off0 + (unsigned)((ai * 128 + m * 16) * NIN + bj * 128) * 2u;
                    const u32x4 wa = *(const u32x4*)(Ub + off + C_GA * 2), wg = *(const u32x4*)(Ub + off + C_GR * 2);
                    float a[8], r[8]; unpack8(wa, a); unpack8(wg, r);
#pragma unroll
                    for (int e = 0; e < 8; ++e) { const float ratio = (1.0f + fast_exp(-r[e])) * __builtin_amdgcn_rcpf(1.0f + fast_exp(-a[e])); acc[ai][bj][m][e >> 2][e & 3] *= ratio; }
                    __builtin_amdgcn_sched_barrier(0);
                } }
    }
    __device__ __forceinline__ void operator()(const f32x4 (&acc)[2][2][4][2], const pg8::Unit& u, int wr, int wc, int fr, int fq) const {
        int row0 = u.pm * 256 + wr * 64 + fr; const int col0 = u.pn * 256 + wc * 32 + 8 * fq;
        asm volatile("" : "+v"(row0));
        const unsigned off0 = ((unsigned)row0 * NIN + col0 + C_GR) * 2u, ooff0 = ((unsigned)row0 * DM + col0) * 2u;
        const char* Ub = (const char*)U; char* Ob = (char*)O;
#pragma unroll
        for (int ai = 0; ai < 2; ++ai)
#pragma unroll
            for (int m = 0; m < 4; ++m) {
#pragma unroll
                for (int bj = 0; bj < 2; ++bj) {
                    const u32x4 wg = *(const u32x4*)(Ub + off0 + (unsigned)((ai * 128 + m * 16) * NIN + bj * 128) * 2u);
                    float r[8], o[8]; unpack8(wg, r);
#pragma unroll
                    for (int e = 0; e < 8; ++e) o[e] = acc[ai][bj][m][e >> 2][e & 3] * sigmoidf_(r[e]);
                    *(u32x4*)(Ob + ooff0 + (unsigned)((ai * 128 + m * 16) * DM + bj * 128) * 2u) = pack8(o);
                    __builtin_amdgcn_sched_barrier(0);
                } }
    }
};
struct EpiOut {
    static constexpr bool PERM = false; static constexpr int MID_T = 0;
    const float* xp; const float* xs; float* yp; float* ys;
    __device__ __forceinline__ void operator()(const f32x4 (&acc)[2][2][4][2], const pg8::Unit& u, int wr, int wc, int fr, int fq) const {
        const int row0 = u.pm * 256 + wr * 64 + fr, col0 = u.pn * 256 + wc * 32 + 4 * fq;
#pragma unroll
        for (int ai = 0; ai < 2; ++ai)
#pragma unroll
            for (int m = 0; m < 4; ++m) { const int row = row0 + ai * 128 + m * 16;
                const float* xr = row < TOKP ? xp + (size_t)row * DM : xs + (size_t)(row - TOKP) * DM;
                float* yr = row < TOKP ? yp + (size_t)row * DM : ys + (size_t)(row - TOKP) * DM;
#pragma unroll
                for (int bj = 0; bj < 2; ++bj)
#pragma unroll
                    for (int n = 0; n < 2; ++n) { const int c = col0 + bj * 128 + n * 16; *(f32x4*)(yr + c) = *(const f32x4*)(xr + c) + acc[ai][bj][m][n]; }
                __builtin_amdgcn_sched_barrier(0); }
    }
};

__device__ __forceinline__ void wtile(const float* W, int N, bf16_t* Wt, int ldt, int koff, int k0, int n0, LAS float* sT, int tid) {
    const int r = tid >> 3, c8 = (tid & 7) * 8;
    const float* src = W + (size_t)(k0 + r) * N + n0 + c8;
    const f32x4 a = *(const f32x4*)src, b = *(const f32x4*)(src + 4);
    LAS float* d = sT + r * 65 + c8;
    d[0] = a[0]; d[1] = a[1]; d[2] = a[2]; d[3] = a[3]; d[4] = b[0]; d[5] = b[1]; d[6] = b[2]; d[7] = b[3];
    __syncthreads();
    float o[8];
#pragma unroll
    for (int i = 0; i < 8; ++i) o[i] = sT[(c8 + i) * 65 + r];
    *(u32x4*)(Wt + (size_t)(n0 + r) * ldt + koff + k0 + c8) = pack8(o);
    __syncthreads();
}
__device__ void phase0(const Params& p, LAS unsigned char* lds) {
    const int tid = threadIdx.x, lane = tid & 63, wid = tid >> 6, bid = blockIdx.x, nb = gridDim.x;
    unsigned char* ws = p.ws;
    { float* cosA = (float*)(ws + OFF_COSA); float* sinA = (float*)(ws + OFF_SINA);
      for (int e = bid * 512 + tid; e < 4116 * 8; e += nb * 512) { const int pidx = e >> 3, i = e & 7; const double pos = pidx < 4112 ? (double)pidx : (double)(16384 + pidx - 4112);
          const double inv = exp(-13.122363377404328 * (2.0 * i / 16.0)); double rev = pos * inv * 0.15915494309189535; rev -= rint(rev);
          cosA[e] = __builtin_amdgcn_cosf((float)rev); sinA[e] = __builtin_amdgcn_sinf((float)rev); }
      float* cosR = (float*)(ws + OFF_COSR); float* sinR = (float*)(ws + OFF_SINR); float* cosRT = (float*)(ws + OFF_COSRT); float* sinRT = (float*)(ws + OFF_SINRT);
      for (int e = bid * 512 + tid; e < 4116 * 64; e += nb * 512) { const int pidx = e >> 6, i = e & 63; const double pos = pidx < 4112 ? (double)pidx : (double)(16384 + pidx - 4112);
          const double inv = exp(-9.210340371976182 * (2.0 * i / 128.0)); double rev = pos * inv * 0.15915494309189535; rev -= rint(rev);
          const float c = __builtin_amdgcn_cosf((float)rev), s = __builtin_amdgcn_sinf((float)rev);
          cosR[e] = c; sinR[e] = s; cosRT[i * TABP + pidx] = c; sinRT[i * TABP + pidx] = s; } }
    { bf16_t* Xn = (bf16_t*)(ws + OFF_XN);
      for (int row = bid * 8 + wid; row < MROWS; row += nb * 8) {
          bf16_t* dst = Xn + (size_t)row * DM;
          const float* src = row < ROW_S ? p.x_prompt + (size_t)row * DM : (row < ROW_M ? p.x_sample + (size_t)(row - ROW_S) * DM : (row < ROW_M + 16 ? p.meta + (size_t)(row - ROW_M) * DM : nullptr));
          if (!src) {
#pragma unroll
              for (int i = 0; i < 4; ++i) *(u32x4*)(dst + (i * 64 + lane) * 8) = (u32x4){0u, 0u, 0u, 0u};
              continue; }
          f32x4 v[8]; float ss = 0.f;
#pragma unroll
          for (int i = 0; i < 8; ++i) { v[i] = *(const f32x4*)(src + (i * 64 + lane) * 4); ss += v[i][0] * v[i][0] + v[i][1] * v[i][1] + v[i][2] * v[i][2] + v[i][3] * v[i][3]; }
#pragma unroll
          for (int o = 1; o < 64; o <<= 1) ss += __shfl_xor(ss, o);
          const float rs = rsqrtf(ss * (1.0f / 2048.0f) + 1e-6f);
#pragma unroll
          for (int i = 0; i < 8; ++i) { const f32x4 g = *(const f32x4*)(p.norm_g + (i * 64 + lane) * 4);
              u32x2 w; w.x = cvt_pk_bf16(v[i][0] * rs * g[0], v[i][1] * rs * g[1]); w.y = cvt_pk_bf16(v[i][2] * rs * g[2], v[i][3] * rs * g[3]);
              *(u32x2*)(dst + (i * 64 + lane) * 4) = w; }
      } }
    { LAS float* sT = (LAS float*)lds;
      bf16_t* WinT = (bf16_t*)(ws + OFF_WINT); bf16_t* WcatT = (bf16_t*)(ws + OFF_WCAT); bf16_t* WoT = (bf16_t*)(ws + OFF_WO);
      for (int t = bid; t < 8960; t += nb) {
          if (t < 6400) { const int kt = t / 200, ntile = t % 200; wtile(p.w_in, NIN, WinT, DM, 0, kt * 64, ntile * 64, sT, tid); }
          else if (t < 6912) { const int q = t - 6400, kt = q >> 5, ntile = q & 31; wtile(p.w_pa, DM, WcatT, KCAT, 0, kt * 64, ntile * 64, sT, tid); }
          else if (t < 7936) { const int q = t - 6912, kt = q >> 5, ntile = q & 31; wtile(p.w_pr, DM, WcatT, KCAT, 1024, kt * 64, ntile * 64, sT, tid); }
          else { const int q = t - 7936, kt = q >> 5, ntile = q & 31; wtile(p.w_o, DM, WoT, DM, 0, kt * 64, ntile * 64, sT, tid); }
      } }
}

__device__ __forceinline__ void headnorm_rope(float (&x)[64], const LAS float* gain, const float* __restrict__ cs, const float* __restrict__ sn, float scale) {
    float ss = 0.f;
#pragma unroll
    for (int d = 0; d < 64; ++d) ss += x[d] * x[d];
    const float rs = rsqrtf(ss * (1.0f / 64.0f) + 1e-6f);
#pragma unroll
    for (int d4 = 0; d4 < 16; ++d4) { const f32x4 g = *(const LAS f32x4*)(gain + d4 * 4); x[d4 * 4] *= rs * g[0]; x[d4 * 4 + 1] *= rs * g[1]; x[d4 * 4 + 2] *= rs * g[2]; x[d4 * 4 + 3] *= rs * g[3]; }
#pragma unroll
    for (int i = 0; i < 8; ++i) { const float c = cs[i], s = sn[i], x1 = x[i], x2 = x[i + 8]; x[i] = x1 * c - x2 * s; x[i + 8] = x2 * c + x1 * s; }
#pragma unroll
    for (int d = 0; d < 64; ++d) x[d] *= scale;
}
__device__ __forceinline__ void load_row64_bf16(const bf16_t* src, float (&x)[64]) {
#pragma unroll
    for (int c = 0; c < 8; ++c) { const u32x4 w = *(const u32x4*)(src + c * 8); unpack8(w, &x[c * 8]); }
}
__device__ __forceinline__ void load_row64_f32(const float* src, float (&x)[64]) {
#pragma unroll
    for (int c = 0; c < 16; ++c) { const f32x4 w = *(const f32x4*)(src + c * 4); x[c * 4] = w[0]; x[c * 4 + 1] = w[1]; x[c * 4 + 2] = w[2]; x[c * 4 + 3] = w[3]; }
}
__device__ __forceinline__ void store_row64_lds(LAS bf16_t* dst, const float (&x)[64]) {
#pragma unroll
    for (int c = 0; c < 8; ++c) *(LAS u32x4*)(dst + c * 8) = pack8(&x[c * 8]);
}
__device__ __forceinline__ void store_row64_f32(float* dst, const float (&x)[64]) {
#pragma unroll
    for (int c = 0; c < 16; ++c) *(f32x4*)(dst + c * 4) = (f32x4){x[c * 4], x[c * 4 + 1], x[c * 4 + 2], x[c * 4 + 3]};
}
template <int NKT, class MaskF>
__device__ __forceinline__ void attn_tile16(const LAS bf16_t* sQ, int qp, const LAS bf16_t* sK, int kp, const LAS bf16_t* sVt, int vp, float sinkv, MaskF mask, f32x4 (&o)[4], int lane) {
    const int fr = lane & 15, fq = lane >> 4;
    bf16x8 qf[2];
#pragma unroll
    for (int ks = 0; ks < 2; ++ks) qf[ks] = *(const LAS bf16x8*)(sQ + fr * qp + ks * 32 + fq * 8);
    f32x4 s[NKT];
#pragma unroll
    for (int kt = 0; kt < NKT; ++kt) { s[kt] = (f32x4){0.f, 0.f, 0.f, 0.f};
#pragma unroll
        for (int ks = 0; ks < 2; ++ks) { const bf16x8 kf = *(const LAS bf16x8*)(sK + (kt * 16 + fr) * kp + ks * 32 + fq * 8); s[kt] = __builtin_amdgcn_mfma_f32_16x16x32_bf16(kf, qf[ks], s[kt], 0, 0, 0); } }
    float mx = sinkv;
#pragma unroll
    for (int kt = 0; kt < NKT; ++kt)
#pragma unroll
        for (int r = 0; r < 4; ++r) { const float v = mask(kt * 16 + fq * 4 + r) ? s[kt][r] : -1e30f; s[kt][r] = v; mx = fmaxf(mx, v); }
    mx = fmaxf(mx, __shfl_xor(mx, 16)); mx = fmaxf(mx, __shfl_xor(mx, 32));
    float sum = 0.f;
#pragma unroll
    for (int kt = 0; kt < NKT; ++kt)
#pragma unroll
        for (int r = 0; r < 4; ++r) { const float pe = fast_exp(s[kt][r] - mx); s[kt][r] = pe; sum += pe; }
    sum += __shfl_xor(sum, 16); sum += __shfl_xor(sum, 32);
    sum += fast_exp(sinkv - mx);
    const float inv = 1.0f / sum;
#pragma unroll
    for (int dt = 0; dt < 4; ++dt) o[dt] = (f32x4){0.f, 0.f, 0.f, 0.f};
#pragma unroll
    for (int k2 = 0; k2 < NKT / 2; ++k2) {
        u32x4 pw; pw.x = cvt_pk_bf16(s[2 * k2][0], s[2 * k2][1]); pw.y = cvt_pk_bf16(s[2 * k2][2], s[2 * k2][3]); pw.z = cvt_pk_bf16(s[2 * k2 + 1][0], s[2 * k2 + 1][1]); pw.w = cvt_pk_bf16(s[2 * k2 + 1][2], s[2 * k2 + 1][3]);
        const bf16x8 pf = __builtin_bit_cast(bf16x8, pw);
#pragma unroll
        for (int dt = 0; dt < 4; ++dt) { const LAS bf16_t* vr = sVt + (dt * 16 + fr) * vp + k2 * 32 + fq * 4;
            const u32x2 lo = *(const LAS u32x2*)vr, hi = *(const LAS u32x2*)(vr + 16);
            const u32x4 vw = (u32x4){lo.x, lo.y, hi.x, hi.y};
            o[dt] = __builtin_amdgcn_mfma_f32_16x16x32_bf16(__builtin_bit_cast(bf16x8, vw), pf, o[dt], 0, 0, 0); }
    }
#pragma unroll
    for (int dt = 0; dt < 4; ++dt) o[dt] *= inv;
}

__device__ void attn_prompt_item(const Params& p, LAS unsigned char* lds, int item) {
    int tid_ = threadIdx.x; asm volatile("" : "+v"(tid_)); const int tid = tid_, lane = tid & 63, wid = tid >> 6;
    const int kvh = item & 3, blk = (item >> 2) & 31, b = item >> 7;
    const bf16_t* U = (const bf16_t*)(p.ws + OFF_U); const bf16_t* UT = (const bf16_t*)(p.ws + OFF_UT); bf16_t* Acat = (bf16_t*)(p.ws + OFF_ACAT);
    const float* cosA = (const float*)(p.ws + OFF_COSA); const float* sinA = (const float*)(p.ws + OFF_SINA);
    constexpr int QP = 72, KP = 72, VP = 296;
    LAS bf16_t* sQ = (LAS bf16_t*)lds; LAS bf16_t* sK = sQ + 512 * QP; LAS bf16_t* sVt = sK + 288 * KP; LAS float* sG = (LAS float*)(sVt + 64 * VP);
    const int tok0 = blk * 128;
    if (tid < 128) sG[tid] = tid < 64 ? p.q_g[tid] : p.k_g[tid - 64];
    __syncthreads();
    {
        const int g = tid >> 7, tok = tid & 127; const int row = b * 4096 + tok0 + tok; const int pidx = 16 + tok0 + tok;
        float x[64]; load_row64_bf16(U + (size_t)row * NIN + C_QA + (kvh * 4 + g) * 64, x);
        headnorm_rope(x, sG, cosA + pidx * 8, sinA + pidx * 8, 0.125f);
        store_row64_lds(sQ + tid * QP, x);
    }
    __builtin_amdgcn_sched_barrier(0);
    if (tid < 288) {
        float x[64];
        int row = -1, pidx = 0;
        if (tid < 16) { row = ROW_M + tid; pidx = tid; }
        else if (tid < 272) { const int tk = tok0 - 128 + (tid - 16); if (tk >= 0) { row = b * 4096 + tk; pidx = 16 + tk; } }
        if (row >= 0) { load_row64_bf16(U + (size_t)row * NIN + C_KA + kvh * 64, x); headnorm_rope(x, sG + 64, cosA + pidx * 8, sinA + pidx * 8, 1.0f); }
        else {
#pragma unroll
            for (int d = 0; d < 64; ++d) x[d] = 0.f; }
        store_row64_lds(sK + tid * KP, x);
        if (blk == 31 && tid >= 144 && tid < 272) store_row64_f32(p.out + O_WKP + ((size_t)(b * 128 + (tid - 144)) * 4 + kvh) * 64, x);
    }
    for (int c = tid; c < 64 * 37; c += 512) { const int d = c / 37, ch = c % 37; u32x4 w = (u32x4){0u, 0u, 0u, 0u};
        const bf16_t* src = UT + (size_t)(UT_VA + kvh * 64 + d) * UTP;
        if (ch < 2) w = *(const u32x4*)(src + ROW_M + ch * 8);
        else if (ch < 34) { const int tk = tok0 - 128 + (ch - 2) * 8; if (tk >= 0) w = *(const u32x4*)(src + b * 4096 + tk); }
        *(LAS u32x4*)(sVt + d * VP + ch * 8) = w; }
    if (blk == 31) for (int e = tid; e < 128 * 64; e += 512) { const int tk = e >> 6, d = e & 63;
        p.out[O_WVP + ((size_t)(b * 128 + tk) * 4 + kvh) * 64 + d] = bf2f(U[(size_t)(b * 4096 + 3968 + tk) * NIN + C_VA + kvh * 64 + d]); }
    __syncthreads();
    const int g = wid >> 1, half = wid & 1, fr = lane & 15, fq = lane >> 4;
    const float sinkv = p.sinks[kvh * 4 + g];
#pragma unroll 1
    for (int mt_ = 0; mt_ < 4; ++mt_) {
        int mt = mt_; asm volatile("" : "+s"(mt));
        const int qi = half * 64 + mt * 16 + fr;
        f32x4 o[4];
        auto mask = [&](int kidx) -> bool { const int kj = kidx - 144; return kidx < 16 || (kidx < 272 && kj <= qi && kj > qi - 128 && tok0 + kj >= 0); };
        attn_tile16<18>(sQ + (g * 128 + half * 64 + mt * 16) * QP, QP, sK, KP, sVt, VP, sinkv, mask, o, lane);
        const size_t row = (size_t)(b * 4096 + tok0 + qi); const int hc = (kvh * 4 + g) * 64;
#pragma unroll
        for (int dt = 0; dt < 4; ++dt) { const int d = dt * 16 + fq * 4;
            const u32x2 zw = *(const u32x2*)(U + row * NIN + C_ZA + hc + d);
            u32x2 w; w.x = cvt_pk_bf16(o[dt][0] * siluf_(bf_lo(zw.x)), o[dt][1] * siluf_(bf_hi(zw.x))); w.y = cvt_pk_bf16(o[dt][2] * siluf_(bf_lo(zw.y)), o[dt][3] * siluf_(bf_hi(zw.y)));
            *(u32x2*)(Acat + row * KCAT + hc + d) = w; }
    }
    __syncthreads();
}

__device__ void attn_sample_item(const Params& p, LAS unsigned char* lds, int item) {
    int tid_ = threadIdx.x; asm volatile("" : "+v"(tid_)); const int tid = tid_, lane = tid & 63, wid = tid >> 6;
    const int kvh = item & 3, bs = item >> 2;
    const bf16_t* U = (const bf16_t*)(p.ws + OFF_U); const bf16_t* UT = (const bf16_t*)(p.ws + OFF_UT); bf16_t* Acat = (bf16_t*)(p.ws + OFF_ACAT);
    const float* cosA = (const float*)(p.ws + OFF_COSA); const float* sinA = (const float*)(p.ws + OFF_SINA);
    constexpr int QP = 72, KP = 72, VP = 168;
    LAS bf16_t* sQ = (LAS bf16_t*)lds; LAS bf16_t* sK = sQ + 16 * QP; LAS bf16_t* sVt = sK + 160 * KP; LAS float* sG = (LAS float*)(sVt + 64 * VP);
    if (tid < 128) sG[tid] = tid < 64 ? p.q_g[tid] : p.k_g[tid - 64];
    __syncthreads();
    if (tid < 160) {
        float x[64];
        if (tid < 16) { load_row64_bf16(U + (size_t)(ROW_M + tid) * NIN + C_KA + kvh * 64, x); headnorm_rope(x, sG + 64, cosA + tid * 8, sinA + tid * 8, 1.0f); }
        else if (tid < 144) { const int c = tid - 16; load_row64_f32(p.cache_k + ((size_t)(bs * 128 + c) * 4 + kvh) * 64, x);
            if (c >= 4) store_row64_f32(p.out + O_WKS + ((size_t)(bs * 128 + c - 4) * 4 + kvh) * 64, x); }
        else if (tid < 148) { const int i = tid - 144; load_row64_bf16(U + (size_t)(ROW_S + bs * 4 + i) * NIN + C_KA + kvh * 64, x);
            headnorm_rope(x, sG + 64, cosA + (4112 + i) * 8, sinA + (4112 + i) * 8, 1.0f);
            store_row64_f32(p.out + O_WKS + ((size_t)(bs * 128 + 124 + i) * 4 + kvh) * 64, x); }
        else {
#pragma unroll
            for (int d = 0; d < 64; ++d) x[d] = 0.f; }
        store_row64_lds(sK + tid * KP, x);
    } else if (tid >= 192 && tid < 208) {
        const int r = tid - 192, g = r >> 2, i = r & 3;
        float x[64]; load_row64_bf16(U + (size_t)(ROW_S + bs * 4 + i) * NIN + C_QA + (kvh * 4 + g) * 64, x);
        headnorm_rope(x, sG, cosA + (4112 + i) * 8, sinA + (4112 + i) * 8, 0.125f);
        store_row64_lds(sQ + r * QP, x);
    }
    for (int e = tid; e < 168 * 64; e += 512) { const int d = e & 63, key = e >> 6; float v = 0.f;
        if (key < 16) v = bf2f(UT[(size_t)(UT_VA + kvh * 64 + d) * UTP + ROW_M + key]);
        else if (key < 144) { const int c = key - 16; v = p.cache_v[((size_t)(bs * 128 + c) * 4 + kvh) * 64 + d]; if (c >= 4) p.out[O_WVS + ((size_t)(bs * 128 + c - 4) * 4 + kvh) * 64 + d] = v; }
        else if (key < 148) { const int i = key - 144; v = bf2f(U[(size_t)(ROW_S + bs * 4 + i) * NIN + C_VA + kvh * 64 + d]); p.out[O_WVS + ((size_t)(bs * 128 + 124 + i) * 4 + kvh) * 64 + d] = v; }
        sVt[d * VP + key] = f2bf(v); }
    __syncthreads();
    if (wid == 0) {
        const int fr = lane & 15, fq = lane >> 4, g = fr >> 2, i = fr & 3;
        const float sinkv = p.sinks[kvh * 4 + g];
        f32x4 o[4];
        auto mask = [&](int kidx) -> bool { return kidx < 16 || (kidx < 144 ? (kidx - 16) > i : (kidx < 148 && (kidx - 144) <= i)); };
        attn_tile16<10>(sQ, QP, sK, KP, sVt, VP, sinkv, mask, o, lane);
        const size_t row = (size_t)(ROW_S + bs * 4 + i); const int hc = (kvh * 4 + g) * 64;
#pragma unroll
        for (int dt = 0; dt < 4; ++dt) { const int d = dt * 16 + fq * 4;
            const u32x2 zw = *(const u32x2*)(U + row * NIN + C_ZA + hc + d);
            u32x2 w; w.x = cvt_pk_bf16(o[dt][0] * siluf_(bf_lo(zw.x)), o[dt][1] * siluf_(bf_hi(zw.x))); w.y = cvt_pk_bf16(o[dt][2] * siluf_(bf_lo(zw.y)), o[dt][3] * siluf_(bf_hi(zw.y)));
            *(u32x2*)(Acat + row * KCAT + hc + d) = w; }
    }
    __syncthreads();
}

__device__ void ret_chunk_item(const Params& p, LAS unsigned char* lds, int item) {
    int tid_ = threadIdx.x; asm volatile("" : "+v"(tid_)); const int tid = tid_, lane = tid & 63, wid = tid >> 6, fr = lane & 15, fq = lane >> 4;
    const bf16_t* UT = (const bf16_t*)(p.ws + OFF_UT);
    const float* cosRT = (const float*)(p.ws + OFF_COSRT); const float* sinRT = (const float*)(p.ws + OFF_SINRT);
    int h, tokrow0, pidx0, C, nks; float* dst;
    if (item < 512) { h = item & 7; const int c = (item >> 3) & 31, b = item >> 8; tokrow0 = b * 4096 + c * 128; pidx0 = 16 + c * 128; C = 128; nks = 4; dst = (float*)(p.ws + OFF_UCT) + (size_t)item * 32768; }
    else { h = item - 512; tokrow0 = ROW_M; pidx0 = 0; C = 16; nks = 1; dst = (float*)(p.ws + OFF_SMT) + (size_t)h * 32768; }
    const int ntok = nks * 32;
    constexpr int TP = 136;
    LAS bf16_t* sKt = (LAS bf16_t*)lds; LAS bf16_t* sVt = sKt + 128 * TP;
    const float lg2 = lg2_of(h);
    const int nch = ntok >> 3;
    for (int t = tid; t < 64 * nch; t += 512) { const int i = t / nch, ch = t % nch;
        const bf16_t* s1 = UT + (size_t)(UT_KR + h * 128 + i) * UTP + tokrow0 + ch * 8;
        const u32x4 wa = *(const u32x4*)s1, wb = *(const u32x4*)(s1 + (size_t)64 * UTP);
        float a[8], bb[8], cs[8], sn[8], o1[8], o2[8]; unpack8(wa, a); unpack8(wb, bb);
        const float* cp = cosRT + i * TABP + pidx0 + ch * 8; const float* sp = sinRT + i * TABP + pidx0 + ch * 8;
        const f32x4 c0 = *(const f32x4*)cp, c1 = *(const f32x4*)(cp + 4), s0 = *(const f32x4*)sp, s1v = *(const f32x4*)(sp + 4);
        cs[0] = c0[0]; cs[1] = c0[1]; cs[2] = c0[2]; cs[3] = c0[3]; cs[4] = c1[0]; cs[5] = c1[1]; cs[6] = c1[2]; cs[7] = c1[3];
        sn[0] = s0[0]; sn[1] = s0[1]; sn[2] = s0[2]; sn[3] = s0[3]; sn[4] = s1v[0]; sn[5] = s1v[1]; sn[6] = s1v[2]; sn[7] = s1v[3];
#pragma unroll
        for (int e = 0; e < 8; ++e) { const int j = ch * 8 + e; const float w = j < C ? 0.08838834764831845f * __builtin_amdgcn_exp2f((float)(C - 1 - j) * lg2) : 0.f;
            o1[e] = (a[e] * cs[e] - bb[e] * sn[e]) * w; o2[e] = (bb[e] * cs[e] + a[e] * sn[e]) * w; }
        *(LAS u32x4*)(sKt + i * TP + ch * 8) = pack8(o1); *(LAS u32x4*)(sKt + (i + 64) * TP + ch * 8) = pack8(o2); }
    for (int t = tid; t < 256 * nch; t += 512) { const int dv = t / nch, ch = t % nch;
        *(LAS u32x4*)(sVt + dv * TP + ch * 8) = *(const u32x4*)(UT + (size_t)(UT_VR + h * 256 + dv) * UTP + tokrow0 + ch * 8); }
    __syncthreads();
    {
        bf16x8 af[4];
#pragma unroll
        for (int ks = 0; ks < 4; ++ks) af[ks] = ks < nks ? *(const LAS bf16x8*)(sKt + (wid * 16 + fr) * TP + ks * 32 + fq * 8) : (bf16x8){0, 0, 0, 0, 0, 0, 0, 0};
#pragma unroll 4
        for (int nt = 0; nt < 16; ++nt) { f32x4 acc = (f32x4){0.f, 0.f, 0.f, 0.f};
#pragma unroll
            for (int ks = 0; ks < 4; ++ks) if (ks < nks) { const bf16x8 bf = *(const LAS bf16x8*)(sVt + (nt * 16 + fr) * TP + ks * 32 + fq * 8); acc = __builtin_amdgcn_mfma_f32_16x16x32_bf16(af[ks], bf, acc, 0, 0, 0); }
            *(f32x4*)(dst + (size_t)(nt * 16 + fr) * 128 + wid * 16 + fq * 4) = acc; }
    }
    __syncthreads();
}

__device__ void ret_sample_item(const Params& p, LAS unsigned char* lds, int item) {
    int tid_ = threadIdx.x; asm volatile("" : "+v"(tid_)); const int tid = tid_, lane = tid & 63, wid = tid >> 6;
    const int h = item & 7, bs = item >> 3;
    const bf16_t* U = (const bf16_t*)(p.ws + OFF_U); bf16_t* Acat = (bf16_t*)(p.ws + OFF_ACAT);
    const float* cosR = (const float*)(p.ws + OFF_COSR); const float* sinR = (const float*)(p.ws + OFF_SINR);
    LAS float* sq = (LAS float*)lds;
    LAS float* sk = sq + 512;
    LAS float* sv = sk + 512;
    LAS float* sdot = sv + 1024;
    LAS float* sred = sdot + 16;
    LAS float* red = sred + 48;
    const float lg2 = lg2_of(h);
    {
        const int which = tid >> 8, i = (tid >> 6) & 3, dd = tid & 63;
        const bf16_t* src = U + (size_t)(ROW_S + bs * 4 + i) * NIN + (which ? C_KR : C_QR) + h * 128;
        const float x1 = bf2f(src[dd]), x2 = bf2f(src[dd + 64]);
        const float c = cosR[(4112 + i) * 64 + dd], s = sinR[(4112 + i) * 64 + dd];
        const float sc = which ? 0.08838834764831845f : 1.0f;
        LAS float* d = (which ? sk : sq) + i * 128;
        d[dd] = (x1 * c - x2 * s) * sc; d[dd + 64] = (x2 * c + x1 * s) * sc;
        for (int e = tid; e < 1024; e += 512) { const int ii = e >> 8, dv = e & 255; sv[e] = bf2f(U[(size_t)(ROW_S + bs * 4 + ii) * NIN + C_VR + h * 256 + dv]); }
    }
    __syncthreads();
    {
        const int gi = tid >> 5, l32 = tid & 31, i = gi >> 2, j = gi & 3;
        float s = 0.f;
#pragma unroll
        for (int m = 0; m < 4; ++m) s += sq[i * 128 + l32 + 32 * m] * sk[j * 128 + l32 + 32 * m];
#pragma unroll
        for (int o = 1; o < 32; o <<= 1) s += __shfl_xor(s, o);
        if (l32 == 0) sdot[gi] = s;
    }
    const int dv4 = lane * 4;
    f32x4 vj[4];
#pragma unroll
    for (int j = 0; j < 4; ++j) vj[j] = *(const LAS f32x4*)(sv + j * 256 + dv4);
    const float g1 = __builtin_amdgcn_exp2f(lg2), g2 = g1 * g1, g3 = g2 * g1, g4 = g2 * g2;
    f32x4 qS[4];
#pragma unroll
    for (int i = 0; i < 4; ++i) qS[i] = (f32x4){0.f, 0.f, 0.f, 0.f};
    const size_t sbase = ((size_t)(bs * 8 + h) * 128 + wid * 16) * 256 + dv4;
    const float* Sp = p.state + sbase; float* So = p.out + O_RS + sbase;
    f32x4 S[16];
#pragma unroll
    for (int e = 0; e < 16; ++e) S[e] = *(const f32x4*)(Sp + (size_t)e * 256);
#pragma unroll
    for (int e = 0; e < 16; ++e) { const int dk = wid * 16 + e;
#pragma unroll
        for (int i = 0; i < 4; ++i) qS[i] += sq[i * 128 + dk] * S[e];
        const f32x4 sn = g4 * S[e] + (g3 * sk[dk]) * vj[0] + (g2 * sk[128 + dk]) * vj[1] + (g1 * sk[256 + dk]) * vj[2] + sk[384 + dk] * vj[3];
        *(f32x4*)(So + (size_t)e * 256) = sn; }
#pragma unroll
    for (int i = 0; i < 4; ++i) *(LAS f32x4*)(red + (wid * 4 + i) * 256 + dv4) = qS[i];
    __syncthreads();
    const int i = tid >> 7, dv2 = (tid & 127) * 2;
    float o0 = 0.f, o1 = 0.f;
#pragma unroll
    for (int w = 0; w < 8; ++w) { o0 += red[(w * 4 + i) * 256 + dv2]; o1 += red[(w * 4 + i) * 256 + dv2 + 1]; }
    const float gi1 = __builtin_amdgcn_exp2f((float)(i + 1) * lg2);
    o0 *= gi1; o1 *= gi1;
#pragma unroll
    for (int j = 0; j < 4; ++j) if (j <= i) { const float cf = sdot[i * 4 + j] * __builtin_amdgcn_exp2f((float)(i - j) * lg2); o0 += cf * sv[j * 256 + dv2]; o1 += cf * sv[j * 256 + dv2 + 1]; }
    float s = o0 + o1;
#pragma unroll
    for (int o = 1; o < 64; o <<= 1) s += __shfl_xor(s, o);
    if (lane == 0) sred[wid] = s;
    __syncthreads();
    const float mean = (sred[2 * i] + sred[2 * i + 1]) * (1.0f / 256.0f);
    const float d0 = o0 - mean, d1 = o1 - mean;
    float q = d0 * d0 + d1 * d1;
#pragma unroll
    for (int o = 1; o < 64; o <<= 1) q += __shfl_xor(q, o);
    if (lane == 0) sred[8 + wid] = q;
    __syncthreads();
    const float var = (sred[8 + 2 * i] + sred[8 + 2 * i + 1]) * (1.0f / 256.0f);
    const float rstd = rsqrtf(var + 1e-5f);
    const size_t row = (size_t)(ROW_S + bs * 4 + i); const int cc = h * 256 + dv2;
    const unsigned zw = *(const unsigned*)(U + row * NIN + C_ZR + cc);
    const float y0 = (d0 * rstd * p.gn_g[cc] + p.gn_b[cc]) * siluf_(bf_lo(zw)), y1 = (d1 * rstd * p.gn_g[cc + 1] + p.gn_b[cc + 1]) * siluf_(bf_hi(zw));
    *(unsigned*)(Acat + row * KCAT + 1024 + cc) = cvt_pk_bf16(y0, y1);
    __syncthreads();
}

__device__ void phase3_scan(const Params& p) {
    const int gt = blockIdx.x * 512 + threadIdx.x;
    if (gt >= 131072) return;
    const int b = gt >> 16, h = (gt >> 13) & 7, rem = gt & 8191;
    const float* UcT = (const float*)(p.ws + OFF_UCT); const float* SmT = (const float*)(p.ws + OFF_SMT); bf16_t* SpT = (bf16_t*)(p.ws + OFF_SPT);
    const float g128 = __builtin_amdgcn_exp2f(128.0f * lg2_of(h));
    f32x4 S = *(const f32x4*)(SmT + (size_t)h * 32768 + rem * 4);
#pragma unroll 8
    for (int c = 0; c < 32; ++c) { const size_t off = ((size_t)((b * 32 + c) * 8 + h)) * 32768 + rem * 4;
        u32x2 w; w.x = cvt_pk_bf16(S[0], S[1]); w.y = cvt_pk_bf16(S[2], S[3]); *(u32x2*)(SpT + off) = w;
        const f32x4 u = *(const f32x4*)(UcT + off); S = g128 * S + u; }
    const int dv = rem >> 5, dk = (rem & 31) * 4;
    float* o = p.out + O_RP + ((size_t)(b * 8 + h) * 128 + dk) * 256 + dv;
    o[0] = S[0]; o[256] = S[1]; o[512] = S[2]; o[768] = S[3];
}

__device__ void ret_out_item(const Params& p, LAS unsigned char* lds, int item) {
    int tid_ = threadIdx.x; asm volatile("" : "+v"(tid_)); const int tid = tid_, lane = tid & 63, wid = tid >> 6, fr = lane & 15, fq = lane >> 4;
    const int h = item & 7, c = (item >> 3) & 31, b = item >> 8;
    const bf16_t* U = (const bf16_t*)(p.ws + OFF_U); const bf16_t* UT = (const bf16_t*)(p.ws + OFF_UT); bf16_t* Acat = (bf16_t*)(p.ws + OFF_ACAT);
    const bf16_t* SpT = (const bf16_t*)(p.ws + OFF_SPT) + (size_t)item * 32768;
    const float* cosR = (const float*)(p.ws + OFF_COSR); const float* sinR = (const float*)(p.ws + OFF_SINR);
    constexpr int TP = 136;
    LAS bf16_t* sK = (LAS bf16_t*)lds; LAS bf16_t* sX = sK + 128 * TP;
    const int tokrow0 = b * 4096 + c * 128, pidx0 = 16 + c * 128;
    const float lg2 = lg2_of(h);
    bf16x8 qf[4];
    { const int i = wid * 16 + fr; const bf16_t* src = U + (size_t)(tokrow0 + i) * NIN + C_QR + h * 128 + fq * 8;
      float x[4][8];
#pragma unroll
      for (int ks = 0; ks < 4; ++ks) { const u32x4 w = *(const u32x4*)(src + ks * 32); unpack8(w, x[ks]); }
#pragma unroll
      for (int ks = 0; ks < 2; ++ks) { const float* cp = cosR + (size_t)(pidx0 + i) * 64 + ks * 32 + fq * 8; const float* sp = sinR + (size_t)(pidx0 + i) * 64 + ks * 32 + fq * 8;
          const f32x4 c0 = *(const f32x4*)cp, c1 = *(const f32x4*)(cp + 4), s0 = *(const f32x4*)sp, s1 = *(const f32x4*)(sp + 4);
#pragma unroll
          for (int e = 0; e < 8; ++e) { const float cs = e < 4 ? c0[e & 3] : c1[e & 3], sn = e < 4 ? s0[e & 3] : s1[e & 3]; const float x1 = x[ks][e], x2 = x[ks + 2][e];
              x[ks][e] = x1 * cs - x2 * sn; x[ks + 2][e] = x2 * cs + x1 * sn; } }
#pragma unroll
      for (int ks = 0; ks < 4; ++ks) qf[ks] = __builtin_bit_cast(bf16x8, pack8(x[ks])); }
    for (int t = tid; t < 1024; t += 512) { const int j = t >> 3, ch = t & 7;
        const bf16_t* src = U + (size_t)(tokrow0 + j) * NIN + C_KR + h * 128 + ch * 8;
        const u32x4 wa = *(const u32x4*)src, wb = *(const u32x4*)(src + 64);
        float a[8], bb[8], o1[8], o2[8]; unpack8(wa, a); unpack8(wb, bb);
        const float* cp = cosR + (size_t)(pidx0 + j) * 64 + ch * 8; const float* sp = sinR + (size_t)(pidx0 + j) * 64 + ch * 8;
        const f32x4 c0 = *(const f32x4*)cp, c1 = *(const f32x4*)(cp + 4), s0 = *(const f32x4*)sp, s1 = *(const f32x4*)(sp + 4);
#pragma unroll
        for (int e = 0; e < 8; ++e) { const float cs = e < 4 ? c0[e & 3] : c1[e & 3], sn = e < 4 ? s0[e & 3] : s1[e & 3];
            o1[e] = (a[e] * cs - bb[e] * sn) * 0.08838834764831845f; o2[e] = (bb[e] * cs + a[e] * sn) * 0.08838834764831845f; }
        *(LAS u32x4*)(sK + j * TP + ch * 8) = pack8(o1); *(LAS u32x4*)(sK + j * TP + 64 + ch * 8) = pack8(o2); }
    for (int t = tid; t < 4096; t += 512) { const int dv = t >> 4, ch = t & 15;
        *(LAS u32x4*)(sX + dv * TP + ch * 8) = *(const u32x4*)(UT + (size_t)(UT_VR + h * 256 + dv) * UTP + tokrow0 + ch * 8); }
    __syncthreads();
    const int iq = wid * 16 + fr;
    bf16x8 pf[4];
#pragma unroll
    for (int k2 = 0; k2 < 4; ++k2) {
        u32x4 pw = (u32x4){0u, 0u, 0u, 0u};
        if (2 * k2 <= wid) {
            f32x4 s0 = (f32x4){0.f, 0.f, 0.f, 0.f}, s1 = (f32x4){0.f, 0.f, 0.f, 0.f};
#pragma unroll
            for (int ks = 0; ks < 4; ++ks) { const bf16x8 k0 = *(const LAS bf16x8*)(sK + (k2 * 32 + fr) * TP + ks * 32 + fq * 8), k1 = *(const LAS bf16x8*)(sK + (k2 * 32 + 16 + fr) * TP + ks * 32 + fq * 8);
                s0 = __builtin_amdgcn_mfma_f32_16x16x32_bf16(k0, qf[ks], s0, 0, 0, 0); s1 = __builtin_amdgcn_mfma_f32_16x16x32_bf16(k1, qf[ks], s1, 0, 0, 0); }
            float v[8];
#pragma unroll
            for (int r = 0; r < 4; ++r) { const int j0 = k2 * 32 + fq * 4 + r, j1 = j0 + 16;
                v[r] = j0 <= iq ? s0[r] * __builtin_amdgcn_exp2f(-(float)(j0 + 1) * lg2) : 0.f; v[4 + r] = j1 <= iq ? s1[r] * __builtin_amdgcn_exp2f(-(float)(j1 + 1) * lg2) : 0.f; }
            pw = pack8(v);
        }
        pf[k2] = __builtin_bit_cast(bf16x8, pw);
    }
    f32x4 o[16];
#pragma unroll
    for (int dt = 0; dt < 16; ++dt) { o[dt] = (f32x4){0.f, 0.f, 0.f, 0.f};
#pragma unroll
        for (int k2 = 0; k2 < 4; ++k2) if (2 * k2 <= wid) { const LAS bf16_t* vr = sX + (dt * 16 + fr) * TP + k2 * 32 + fq * 4;
            const u32x2 lo = *(const LAS u32x2*)vr, hi = *(const LAS u32x2*)(vr + 16); const u32x4 vw = (u32x4){lo.x, lo.y, hi.x, hi.y};
            o[dt] = __builtin_amdgcn_mfma_f32_16x16x32_bf16(__builtin_bit_cast(bf16x8, vw), pf[k2], o[dt], 0, 0, 0); } }
    __syncthreads();
    for (int t = tid; t < 4096; t += 512) { const int dv = t >> 4, ch = t & 15; *(LAS u32x4*)(sX + dv * TP + ch * 8) = *(const u32x4*)(SpT + (size_t)dv * 128 + ch * 8); }
    __syncthreads();
#pragma unroll
    for (int dt = 0; dt < 16; ++dt)
#pragma unroll
        for (int ks = 0; ks < 4; ++ks) { const bf16x8 sf = *(const LAS bf16x8*)(sX + (dt * 16 + fr) * TP + ks * 32 + fq * 8); o[dt] = __builtin_amdgcn_mfma_f32_16x16x32_bf16(sf, qf[ks], o[dt], 0, 0, 0); }
    const float gi1 = __builtin_amdgcn_exp2f((float)(iq + 1) * lg2);
    float sum = 0.f;
#pragma unroll
    for (int dt = 0; dt < 16; ++dt) { o[dt] *= gi1; sum += (o[dt][0] + o[dt][1]) + (o[dt][2] + o[dt][3]); }
    sum += __shfl_xor(sum, 16); sum += __shfl_xor(sum, 32);
    const float mean = sum * (1.0f / 256.0f);
    float q = 0.f;
#pragma unroll
    for (int dt = 0; dt < 16; ++dt) { o[dt] -= mean; q += (o[dt][0] * o[dt][0] + o[dt][1] * o[dt][1]) + (o[dt][2] * o[dt][2] + o[dt][3] * o[dt][3]); }
    q += __shfl_xor(q, 16); q += __shfl_xor(q, 32);
    const float rstd = rsqrtf(q * (1.0f / 256.0f) + 1e-5f);
    const size_t row = (size_t)(tokrow0 + iq);
#pragma unroll
    for (int dt = 0; dt < 16; ++dt) { const int cc = h * 256 + dt * 16 + fq * 4;
        const f32x4 gg = *(const f32x4*)(p.gn_g + cc), gb = *(const f32x4*)(p.gn_b + cc);
        const u32x2 zw = *(const u32x2*)(U + row * NIN + C_ZR + cc);
        const float y0 = (o[dt][0] * rstd * gg[0] + gb[0]) * siluf_(bf_lo(zw.x)), y1 = (o[dt][1] * rstd * gg[1] + gb[1]) * siluf_(bf_hi(zw.x));
        const float y2 = (o[dt][2] * rstd * gg[2] + gb[2]) * siluf_(bf_lo(zw.y)), y3 = (o[dt][3] * rstd * gg[3] + gb[3]) * siluf_(bf_hi(zw.y));
        u32x2 w; w.x = cvt_pk_bf16(y0, y1); w.y = cvt_pk_bf16(y2, y3);
        *(u32x2*)(Acat + row * KCAT + 1024 + cc) = w; }
    __syncthreads();
}

__global__ void __launch_bounds__(512, 2) mega(Params p) {
    extern __shared__ __attribute__((aligned(16))) unsigned char shm[];
    LAS unsigned char* lds = (LAS unsigned char*)shm;
    cg::grid_group grid = cg::this_grid();
    const int bid = blockIdx.x, nb = gridDim.x;
    unsigned char* ws = p.ws;
#define PH(n) ((n) >= p.ph_lo && (n) < p.ph_hi)
#define SEAM(n) do { if ((n) + 1 > p.ph_lo && (n) + 1 < p.ph_hi) grid.sync(); } while (0)
    if (PH(0)) phase0(p, lds);
    SEAM(0);
    if (PH(1)) { pg8::Gemm g{(const bf16_t*)(ws + OFF_XN), (const bf16_t*)(ws + OFF_WINT), MROWS, NIN, DM}; pg8::StaticOrder S; S.init(g.M, g.N, nb, bid);
        EpiU E{(bf16_t*)(ws + OFF_U), (bf16_t*)(ws + OFF_UT)}; pg8::gemm_phase<EpiU>(lds, g, S, E); }
    SEAM(1);
    if (PH(2)) {
        for (int it = bid; it < 2312; it += nb) {
            if (it < 256) attn_prompt_item(p, lds, it);
            else if (it < 776) ret_chunk_item(p, lds, it - 256);
            else if (it < 1288) attn_sample_item(p, lds, it - 776);
            else ret_sample_item(p, lds, it - 1288);
        }
    }
    SEAM(2);
    if (PH(3)) phase3_scan(p);
    SEAM(3);
    if (PH(4)) { for (int it = bid; it < 512; it += nb) ret_out_item(p, lds, it); }
    SEAM(4);
    if (PH(5)) { pg8::Gemm g{(const bf16_t*)(ws + OFF_ACAT), (const bf16_t*)(ws + OFF_WCAT), MR2, DM, KCAT}; pg8::StaticOrder S; S.init(g.M, g.N, nb, bid);
        EpiMrg E{(const bf16_t*)(ws + OFF_U), (bf16_t*)(ws + OFF_MRG)}; pg8::gemm_phase<EpiMrg>(lds, g, S, E); }
    SEAM(5);
    if (PH(6)) { pg8::Gemm g{(const bf16_t*)(ws + OFF_MRG), (const bf16_t*)(ws + OFF_WO), MR2, DM, DM}; pg8::StaticOrder S; S.init(g.M, g.N, nb, bid);
        EpiOut E{p.x_prompt, p.x_sample, p.out + O_YP, p.out + O_YS}; pg8::gemm_phase<EpiOut>(lds, g, S, E); }
#undef PH
#undef SEAM
}

extern "C" void kernel_launch(void* const* d_in, const int* in_sizes, int n_in, void* d_out, int out_size, void* d_ws, size_t ws_size, hipStream_t stream) {
    static int grid = 0;
    if (grid == 0) {
        if (n_in != 16 || ws_size < WS_END) { fprintf(stderr, "kernel_launch: unexpected n_in %d / ws %zu (need %zu)\n", n_in, ws_size, (size_t)WS_END); grid = -1; return; }
        int dev = 0, cus = 0, per_cu = 0;
        hipGetDevice(&dev); hipDeviceGetAttribute(&cus, hipDeviceAttributeMultiprocessorCount, dev);
        if (hipFuncSetAttribute((const void*)mega, hipFuncAttributeMaxDynamicSharedMemorySize, LDS_BYTES) != hipSuccess) { fprintf(stderr, "kernel_launch: hipFuncSetAttribute failed\n"); grid = -1; return; }
        if (hipOccupancyMaxActiveBlocksPerMultiprocessor(&per_cu, (const void*)mega, 512, LDS_BYTES) != hipSuccess || per_cu < 1) { fprintf(stderr, "kernel_launch: occupancy query says %d\n", per_cu); per_cu = 1; (void)hipGetLastError(); }
        grid = cus;
    }
    if (grid < 0) return;
    Params p{};
    p.x_prompt = (const float*)d_in[0]; p.x_sample = (const float*)d_in[1]; p.cache_k = (const float*)d_in[2]; p.cache_v = (const float*)d_in[3]; p.state = (const float*)d_in[4];
    p.meta = (const float*)d_in[5]; p.norm_g = (const float*)d_in[6]; p.w_in = (const float*)d_in[7]; p.q_g = (const float*)d_in[8]; p.k_g = (const float*)d_in[9]; p.sinks = (const float*)d_in[10];
    p.gn_g = (const float*)d_in[11]; p.gn_b = (const float*)d_in[12]; p.w_pa = (const float*)d_in[13]; p.w_pr = (const float*)d_in[14]; p.w_o = (const float*)d_in[15];
    p.out = (float*)d_out; p.ws = (unsigned char*)d_ws; p.ph_lo = 0; p.ph_hi = 7;
    void* args[] = {&p};
    hipError_t e = hipLaunchCooperativeKernel((const void*)mega, dim3(grid), dim3(512), args, LDS_BYTES, stream);
    if (e != hipSuccess) fprintf(stderr, "cooperative launch failed: %s (grid %d)\n", hipGetErrorString(e), grid);
}
```

```cpp
#include <hip/hip_runtime.h>
#include <hip/hip_cooperative_groups.h>
#include <cstdio>
namespace cg = cooperative_groups;

#define LAS __attribute__((address_space(3)))
typedef unsigned short bf16_t;
typedef short bf16x8 __attribute__((ext_vector_type(8)));
typedef short bf16x4 __attribute__((ext_vector_type(4)));
typedef float f32x4 __attribute__((ext_vector_type(4)));
typedef float f32x2 __attribute__((ext_vector_type(2)));
typedef unsigned u32x4 __attribute__((ext_vector_type(4)));
typedef unsigned u32x2 __attribute__((ext_vector_type(2)));

constexpr int DM = 2048, NIN = 12800, MROWS = 8960, MR2 = 8704, TOKP = 8192, ROW_S = 8192, ROW_M = 8704;
constexpr int C_QA = 0, C_KA = 1024, C_VA = 1280, C_ZA = 1536, C_QR = 2560, C_KR = 3584, C_VR = 4608, C_ZR = 6656, C_GA = 8704, C_GR = 10752;
constexpr int UTP = 8960;
constexpr int UT_VA = 0, UT_KR = 256, UT_VR = 1280;
constexpr int TABP = 4128;
constexpr int KCAT = 3072;
constexpr size_t OFF_XN = 0, OFF_WINT = 36700160, OFF_ACAT = 0, OFF_MRG = 53477376;
constexpr size_t OFF_WCAT = 89128960, OFF_WO = OFF_WCAT + 12582912, OFF_U = OFF_WO + 8388608, OFF_UT = OFF_U + 229376000;
constexpr size_t OFF_UCT = OFF_UT + 59637760, OFF_SMT = OFF_UCT + 67108864, OFF_SPT = OFF_SMT + 1048576, OFF_TAB = OFF_SPT + 33554432;
constexpr size_t OFF_COSA = OFF_TAB, OFF_SINA = OFF_COSA + 132096, OFF_COSR = OFF_SINA + 132096, OFF_SINR = OFF_COSR + 1056768;
constexpr size_t OFF_COSRT = OFF_SINR + 1056768, OFF_SINRT = OFF_COSRT + 1056768, WS_END = OFF_SINRT + 1056768;
constexpr size_t O_YP = 0, O_YS = 16777216, O_WKP = 17825792, O_WVP = 17891328, O_RP = 17956864, O_WKS = 18481152, O_WVS = 22675456, O_RS = 26869760;
constexpr int LDS_BYTES = 160 * 1024;

struct Params {
    const float *x_prompt, *x_sample, *cache_k, *cache_v, *state, *meta, *norm_g, *w_in, *q_g, *k_g, *sinks, *gn_g, *gn_b, *w_pa, *w_pr, *w_o;
    float* out; unsigned char* ws; int ph_lo, ph_hi;
};

__device__ __forceinline__ unsigned cvt_pk_bf16(float lo, float hi) { unsigned r; asm("v_cvt_pk_bf16_f32 %0, %1, %2" : "=v"(r) : "v"(lo), "v"(hi)); return r; }
__device__ __forceinline__ bf16_t f2bf(float f) { return (bf16_t)(cvt_pk_bf16(f, 0.f) & 0xffffu); }
__device__ __forceinline__ float bf_lo(unsigned w) { return __uint_as_float(w << 16); }
__device__ __forceinline__ float bf_hi(unsigned w) { return __uint_as_float(w & 0xffff0000u); }
__device__ __forceinline__ float bf2f(bf16_t h) { return __uint_as_float(((unsigned)h) << 16); }
__device__ __forceinline__ float fast_exp(float x) { return __builtin_amdgcn_exp2f(x * 1.4426950408889634f); }
__device__ __forceinline__ float sigmoidf_(float x) { return __builtin_amdgcn_rcpf(1.0f + fast_exp(-x)); }
__device__ __forceinline__ float siluf_(float x) { return x * sigmoidf_(x); }
__device__ __forceinline__ float lg2_of(int h) {
    float r = -0.04580368961312479f;
    r = h == 1 ? -0.030662988889756927f : r; r = h == 2 ? -0.020562769581231145f : r; r = h == 3 ? -0.013805413024509017f : r;
    r = h == 4 ? -0.009275800472620728f : r; r = h == 5 ? -0.006235583073184706f : r; r = h == 6 ? -0.004193268921546044f : r;
    r = h == 7 ? -0.002820519062378663f : r; return r;
}
__device__ __forceinline__ void unpack8(u32x4 w, float* x) { x[0] = bf_lo(w.x); x[1] = bf_hi(w.x); x[2] = bf_lo(w.y); x[3] = bf_hi(w.y); x[4] = bf_lo(w.z); x[5] = bf_hi(w.z); x[6] = bf_lo(w.w); x[7] = bf_hi(w.w); }
__device__ __forceinline__ u32x4 pack8(const float* x) { u32x4 w; w.x = cvt_pk_bf16(x[0], x[1]); w.y = cvt_pk_bf16(x[2], x[3]); w.z = cvt_pk_bf16(x[4], x[5]); w.w = cvt_pk_bf16(x[6], x[7]); return w; }
__device__ __forceinline__ int pidx_of_row(int row) { return row < ROW_S ? 16 + (row & 4095) : (row < ROW_M ? 4112 + ((row - ROW_S) & 3) : row - ROW_M); }

namespace pg8 {
constexpr int BM = 256, BK = 64, HALF = 128, HTB = HALF * BK * 2, STAGE_BYTES = 8 * HTB, NXCD = 8, WGM = 8;
__device__ __forceinline__ int lds_byte(int r, int c) { const int st = (r >> 4) * 2 + (c >> 5), rr = r & 15, cc = c & 31, ob = rr * 64 + cc * 2; return st * 1024 + (ob ^ (((ob >> 9) & 1) << 5)); }
__device__ __forceinline__ void stage_rc(int b, int& R, int& C) { const int st = b / 1024, sb = b % 1024, swz = sb ^ (((sb >> 9) & 1) << 5); R = (st >> 1) * 16 + swz / 64; C = (st & 1) * 32 + (swz % 64) / 2; }
__device__ __forceinline__ int perm32(int rho) { const int n = rho >> 4, i = rho & 15; return 8 * (i >> 2) + 4 * n + (i & 3); }
struct Unit { int pm, pn; };
struct Gemm { const bf16_t* A; const bf16_t* Bt; int M, N, K; };
struct StaticOrder {
    int nM, nN, nwg, G, c;
    __device__ void init(int M, int N, int G_, int c_) { nM = M / BM; nN = N / BM; nwg = nM * nN; G = G_; c = c_; }
    __device__ bool next(int i, Unit& u) const {
        const long L = (long)i * G + c; if (L >= nwg) return false;
        int wgid = (int)L; { const int q = nwg / NXCD, r = nwg % NXCD, xcd = wgid % NXCD, off = wgid / NXCD; wgid = (xcd < r ? xcd * (q + 1) : r * (q + 1) + (xcd - r) * q) + off; }
        const int nig = WGM * nN, gid = wgid / nig, fm = gid * WGM, gsz = (nM - fm) < WGM ? (nM - fm) : WGM;
        u.pm = fm + ((wgid % nig) % gsz); u.pn = (wgid % nig) / gsz; return true;
    }
};

template <class Epi>
__device__ __forceinline__ void gemm_phase(LAS unsigned char* lds, const Gemm g, const StaticOrder& S, const Epi& E) {
    const int tid = threadIdx.x, wid = __builtin_amdgcn_readfirstlane(tid >> 6), lane = tid & 63, wr = wid >> 2, wc = wid & 3, fr = lane & 15, fq = lane >> 4;
    const int K = g.K, nt = K / BK;
    unsigned voffA[2], voffB[2];
#pragma unroll
    for (int i = 0; i < 2; ++i) { int R, C; stage_rc(tid * 16 + i * 8192, R, C); const int Rb = Epi::PERM ? ((R & ~31) + perm32(R & 31)) : R;
        voffA[i] = (unsigned)(R * K + C) * 2u; voffB[i] = (unsigned)(Rb * K + C) * 2u; }
    const size_t kstep = (size_t)(BK * 2);
    const size_t hstep = (size_t)HALF * K * 2;
    const size_t tstep = 2 * hstep;
    const unsigned ldsw = (unsigned)wid * 1024u;
    const int aoff = lds_byte(wr * 64 + fr, fq * 8), boff = lds_byte(wc * 32 + fr, fq * 8);
#define PG8_SA(b, h) (((b) * 2 + (h)) * HTB)
#define PG8_SB(b, h) ((4 + (b) * 2 + (h)) * HTB)
#define PG8_STAGE(bufoff, gbase, voff) do { _Pragma("unroll") for (int _i = 0; _i < 2; ++_i) \
        __builtin_amdgcn_global_load_lds((const unsigned*)((const char*)(gbase) + (voff)[_i]), (LAS unsigned*)(lds + (bufoff) + ldsw + _i * 8192), 16, 0, 0); } while (0)
#define PG8_LDA(dst, b, h) do { _Pragma("unroll") for (int m = 0; m < 4; ++m) _Pragma("unroll") for (int k = 0; k < 2; ++k) dst[m][k] = *(const LAS bf16x8*)(lds + PG8_SA(b, h) + aoff + m * 2048 + k * 1024); } while (0)
#define PG8_LDB(dst, b, h) do { _Pragma("unroll") for (int n = 0; n < 2; ++n) _Pragma("unroll") for (int k = 0; k < 2; ++k) dst[n][k] = *(const LAS bf16x8*)(lds + PG8_SB(b, h) + boff + n * 2048 + k * 1024); } while (0)
#define PG8_MMA(ai, bj, At, Bt) do { __builtin_amdgcn_s_setprio(1); _Pragma("unroll") for (int m = 0; m < 4; ++m) _Pragma("unroll") for (int n = 0; n < 2; ++n) _Pragma("unroll") for (int k = 0; k < 2; ++k) \
        acc[ai][bj][m][n] = __builtin_amdgcn_mfma_f32_16x16x32_bf16(Bt[n][k], At[m][k], acc[ai][bj][m][n], 0, 0, 0); __builtin_amdgcn_s_setprio(0); } while (0)
#define PG8_WAIT_V(n) asm volatile("s_waitcnt vmcnt(" #n ")" ::: "memory")
#define PG8_WAIT_L(n) asm volatile("s_waitcnt lgkmcnt(" #n ")" ::: "memory")
#define PG8_BAR __builtin_amdgcn_s_barrier()
#define PG8_SCHED __builtin_amdgcn_sched_barrier(0)
#define PG8_KBODY do { \
            const bool last = (t == nt - 2); \
            const char* a1 = cA + (size_t)(t + 1) * kstep; \
            const char* a2 = last ? nA : cA + (size_t)(t + 2) * kstep; const char* b2 = last ? nB : cB + (size_t)(t + 2) * kstep; \
            const char* a3 = a2 + kstep; const char* b3 = b2 + kstep; \
            PG8_LDB(B0, 0, 0); PG8_SCHED; PG8_LDA(At, 0, 0); PG8_STAGE(PG8_SA(1, 1), a1 + hstep, voffA); \
            PG8_WAIT_L(8); PG8_BAR; PG8_WAIT_L(0); PG8_MMA(0, 0, At, B0); PG8_BAR; PG8_SCHED; \
            PG8_LDB(B1, 0, 1); PG8_STAGE(PG8_SB(0, 0), b2, voffB); \
            PG8_BAR; PG8_WAIT_L(0); PG8_MMA(0, 1, At, B1); PG8_BAR; \
            PG8_LDA(At, 0, 1); PG8_STAGE(PG8_SA(0, 0), a2, voffA); \
            PG8_BAR; PG8_WAIT_L(0); PG8_MMA(1, 0, At, B0); PG8_BAR; PG8_SCHED; \
            PG8_STAGE(PG8_SB(0, 1), b2 + hstep, voffB); \
            PG8_WAIT_V(6); PG8_BAR; PG8_MMA(1, 1, At, B1); PG8_BAR; \
            PG8_LDB(B0, 1, 0); PG8_SCHED; PG8_LDA(At, 1, 0); PG8_STAGE(PG8_SA(0, 1), a2 + hstep, voffA); \
            PG8_WAIT_L(8); PG8_BAR; PG8_WAIT_L(0); PG8_MMA(0, 0, At, B0); PG8_BAR; PG8_SCHED; \
            PG8_LDB(B1, 1, 1); PG8_STAGE(PG8_SB(1, 0), b3, voffB); \
            PG8_BAR; PG8_WAIT_L(0); PG8_MMA(0, 1, At, B1); PG8_BAR; \
            PG8_LDA(At, 1, 1); PG8_STAGE(PG8_SA(1, 0), a3, voffA); \
            PG8_BAR; PG8_WAIT_L(0); PG8_MMA(1, 0, At, B0); PG8_BAR; PG8_SCHED; \
            PG8_STAGE(PG8_SB(1, 1), b3 + hstep, voffB); \
            PG8_WAIT_V(6); PG8_BAR; PG8_MMA(1, 1, At, B1); PG8_BAR; \
        } while (0)
    Unit cur, nxt; int ui = 0;
    if (!S.next(0, cur)) return;
    f32x4 acc[2][2][4][2];
#pragma unroll
    for (int a = 0; a < 2; ++a)
#pragma unroll
        for (int b = 0; b < 2; ++b)
#pragma unroll
            for (int m = 0; m < 4; ++m)
#pragma unroll
                for (int n = 0; n < 2; ++n) acc[a][b][m][n] = (f32x4){0.f, 0.f, 0.f, 0.f};
    bf16x8 At[4][2], B0[2][2], B1[2][2];
    const char* cA = (const char*)g.A + (size_t)cur.pm * tstep; const char* cB = (const char*)g.Bt + (size_t)cur.pn * tstep;
    PG8_STAGE(PG8_SB(0, 0), cB, voffB); PG8_STAGE(PG8_SA(0, 0), cA, voffA); PG8_STAGE(PG8_SB(0, 1), cB + hstep, voffB); PG8_STAGE(PG8_SA(0, 1), cA + hstep, voffA);
    if (wr == 1) PG8_BAR;
    PG8_WAIT_V(4); PG8_BAR;
    PG8_STAGE(PG8_SB(1, 0), cB + kstep, voffB); PG8_STAGE(PG8_SA(1, 0), cA + kstep, voffA); PG8_STAGE(PG8_SB(1, 1), cB + hstep + kstep, voffB);
    PG8_WAIT_V(6); PG8_BAR;
    for (;;) {
        const bool has_next = S.next(ui + 1, nxt);
        const char* nA = has_next ? (const char*)g.A + (size_t)nxt.pm * tstep : cA; const char* nB = has_next ? (const char*)g.Bt + (size_t)nxt.pn * tstep : cB;
        if constexpr (Epi::MID_T > 0) {
            for (int t = 0; t < Epi::MID_T; t += 2) PG8_KBODY;
            E.mid(acc, cur, wr, wc, fr, fq);
            for (int t = Epi::MID_T; t < nt; t += 2) PG8_KBODY;
        } else {
            for (int t = 0; t < nt; t += 2) PG8_KBODY;
        }
        E(acc, cur, wr, wc, fr, fq);
        if (!has_next) break;
#pragma unroll
        for (int a = 0; a < 2; ++a)
#pragma unroll
            for (int b = 0; b < 2; ++b)
#pragma unroll
                for (int m = 0; m < 4; ++m)
#pragma unroll
                    for (int n = 0; n < 2; ++n) acc[a][b][m][n] = (f32x4){0.f, 0.f, 0.f, 0.f};
        cur = nxt; cA = nA; cB = nB; ++ui;
    }
    PG8_WAIT_V(0);
    if (wr == 0) PG8_BAR;
    PG8_BAR;
#undef PG8_KBODY
#undef PG8_SA
#undef PG8_SB
#undef PG8_STAGE
#undef PG8_LDA
#undef PG8_LDB
#undef PG8_MMA
#undef PG8_WAIT_V
#undef PG8_WAIT_L
#undef PG8_BAR
#undef PG8_SCHED
}
}

struct EpiU {
    static constexpr bool PERM = true; static constexpr int MID_T = 0;
    bf16_t* U; bf16_t* UT;
    __device__ __forceinline__ void operator()(const f32x4 (&acc)[2][2][4][2], const pg8::Unit& u, int wr, int wc, int fr, int fq) const {
        const int row0 = u.pm * 256 + wr * 64 + fr, col0 = u.pn * 256 + wc * 32 + 8 * fq;
#pragma unroll
        for (int ai = 0; ai < 2; ++ai)
#pragma unroll
            for (int m = 0; m < 4; ++m) { bf16_t* rowp = U + (size_t)(row0 + ai * 128 + m * 16) * NIN + col0;
#pragma unroll
                for (int bj = 0; bj < 2; ++bj) { const f32x4 v0 = acc[ai][bj][m][0], v1 = acc[ai][bj][m][1];
                    u32x4 w; w.x = cvt_pk_bf16(v0[0], v0[1]); w.y = cvt_pk_bf16(v0[2], v0[3]); w.z = cvt_pk_bf16(v1[0], v1[1]); w.w = cvt_pk_bf16(v1[2], v1[3]);
                    *(u32x4*)(rowp + bj * 128) = w; } }
        int trow = -1;
        if (u.pn == 5) trow = UT_VA; else if (u.pn >= 14 && u.pn < 18) trow = UT_KR + (u.pn - 14) * 256; else if (u.pn >= 18 && u.pn < 26) trow = UT_VR + (u.pn - 18) * 256;
        if (trow >= 0) {
            bf16_t* base = UT + (size_t)(trow + wc * 32 + 8 * fq) * UTP + row0;
#pragma unroll
            for (int bj = 0; bj < 2; ++bj)
#pragma unroll
                for (int n = 0; n < 2; ++n)
#pragma unroll
                    for (int j = 0; j < 4; ++j) { bf16_t* cp = base + (size_t)(bj * 128 + 4 * n + j) * UTP;
#pragma unroll
                        for (int ai = 0; ai < 2; ++ai)
#pragma unroll
                            for (int m = 0; m < 4; ++m) cp[ai * 128 + m * 16] = f2bf(acc[ai][bj][m][n][j]); }
        }
    }
};
struct EpiMrg {
    static constexpr bool PERM = true; static constexpr int MID_T = 16;
    const bf16_t* U; bf16_t* O;
    __device__ __forceinline__ void mid(f32x4 (&acc)[2][2][4][2], const pg8::Unit& u, int wr, int wc, int fr, int fq) const {
        int row0 = u.pm * 256 + wr * 64 + fr; const int col0 = u.pn * 256 + wc * 32 + 8 * fq;
        asm volatile("" : "+v"(row0));
        const unsigned off0 = ((unsigned)row0 * NIN + col0) * 2u;
        const char* Ub = (const char*)U;
        u32x4 wa[3], wg[3];
#define GOFF(g) (off0 + (unsigned)(((((g) >> 3) * 128 + (((g) >> 1) & 3) * 16) * NIN + ((g) & 1) * 128) * 2))
#pragma unroll
        for (int g = 0; g < 2; ++g) { wa[g] = *(const u32x4*)(Ub + GOFF(g) + C_GA * 2); wg[g] = *(const u32x4*)(Ub + GOFF(g) + C_GR * 2); }
#pragma unroll
        for (int g = 0; g < 16; ++g) {
            if (g + 2 < 16) { wa[(g + 2) % 3] = *(const u32x4*)(Ub + GOFF(g + 2) + C_GA * 2); wg[(g + 2) % 3] = *(const u32x4*)(Ub + GOFF(g + 2) + C_GR * 2); }
            float a[8], r[8]; unpack8(wa[g % 3], a); unpack8(wg[g % 3], r);
#pragma unroll
            for (int e = 0; e < 8; ++e) { const float ratio = (1.0f + fast_exp(-r[e])) * __builtin_amdgcn_rcpf(1.0f + fast_exp(-a[e])); acc[g >> 3][g & 1][(g >> 1) & 3][e >> 2][e & 3] *= ratio; }
            __builtin_amdgcn_sched_barrier(0);
        }
    }
    __device__ __forceinline__ void operator()(const f32x4 (&acc)[2][2][4][2], const pg8::Unit& u, int wr, int wc, int fr, int fq) const {
        int row0 = u.pm * 256 + wr * 64 + fr; const int col0 = u.pn * 256 + wc * 32 + 8 * fq;
        asm volatile("" : "+v"(row0));
        const unsigned off0 = ((unsigned)row0 * NIN + col0) * 2u, ooff0 = ((unsigned)row0 * DM + col0) * 2u;
        const char* Ub = (const char*)U; char* Ob = (char*)O;
        u32x4 wg[16];
#pragma unroll
        for (int g = 0; g < 16; ++g) wg[g] = *(const u32x4*)(Ub + GOFF(g) + C_GR * 2);
#pragma unroll
        for (int g = 0; g < 16; ++g) {
            float r[8], o[8]; unpack8(wg[g], r);
#pragma unroll
            for (int e = 0; e < 8; ++e) o[e] = acc[g >> 3][g & 1][(g >> 1) & 3][e >> 2][e & 3] * sigmoidf_(r[e]);
            *(u32x4*)(Ob + ooff0 + (unsigned)((((g >> 3) * 128 + ((g >> 1) & 3) * 16) * DM + (g & 1) * 128) * 2)) = pack8(o);
        }
#undef GOFF
    }
};
struct EpiOut {
    static constexpr bool PERM = false; static constexpr int MID_T = 0;
    const float* xp; const float* xs; float* yp; float* ys;
    __device__ __forceinline__ void operator()(const f32x4 (&acc)[2][2][4][2], const pg8::Unit& u, int wr, int wc, int fr, int fq) const {
        int row0 = u.pm * 256 + wr * 64 + fr; const int col0 = u.pn * 256 + wc * 32 + 4 * fq;
        asm volatile("" : "+v"(row0));
        const float* xb = u.pm < 32 ? xp : xs - (size_t)TOKP * DM; float* yb = u.pm < 32 ? yp : ys - (size_t)TOKP * DM;
        const unsigned off0 = ((unsigned)row0 * DM + col0) * 4u;
        const char* Xb = (const char*)xb; char* Yb = (char*)yb;
        f32x4 xv[2][4];
#define GOFF(q, k) (off0 + (unsigned)(((((q) >> 2) * 128 + ((q) & 3) * 16) * DM + ((k) >> 1) * 128 + ((k) & 1) * 16) * 4))
#pragma unroll
        for (int k = 0; k < 4; ++k) xv[0][k] = *(const f32x4*)(Xb + GOFF(0, k));
#pragma unroll
        for (int q = 0; q < 8; ++q) {
            if (q + 1 < 8) {
#pragma unroll
                for (int k = 0; k < 4; ++k) xv[(q + 1) & 1][k] = *(const f32x4*)(Xb + GOFF(q + 1, k)); }
#pragma unroll
            for (int k = 0; k < 4; ++k) *(f32x4*)(Yb + GOFF(q, k)) = xv[q & 1][k] + acc[q >> 2][k >> 1][q & 3][k & 1];
            __builtin_amdgcn_sched_barrier(0);
        }
#undef GOFF
    }
};

__device__ __forceinline__ void wtile(const float* W, int N, bf16_t* Wt, int ldt, int koff, int k0, int n0, LAS float* sT, int tid) {
    const int r = tid >> 3, cg = (tid & 7) * 4;
    const float* src = W + (size_t)(k0 + r) * N + n0 + cg;
    f32x4 v[4];
#pragma unroll
    for (int q = 0; q < 4; ++q) v[q] = __builtin_nontemporal_load((const f32x4*)(src + q * 32));
#pragma unroll
    for (int q = 0; q < 4; ++q) { LAS float* d = sT + r * 129 + cg + q * 32; d[0] = v[q][0]; d[1] = v[q][1]; d[2] = v[q][2]; d[3] = v[q][3]; }
    __syncthreads();
    const int n = tid >> 2, k8 = (tid & 3) * 8;
#pragma unroll
    for (int hlf = 0; hlf < 2; ++hlf) { float o[8];
#pragma unroll
        for (int i = 0; i < 8; ++i) o[i] = sT[(k8 + hlf * 32 + i) * 129 + n];
        *(u32x4*)(Wt + (size_t)(n0 + n) * ldt + koff + k0 + k8 + hlf * 32) = pack8(o); }
    __syncthreads();
}
__device__ void phase0(const Params& p, LAS unsigned char* lds) {
    const int tid = threadIdx.x, lane = tid & 63, wid = tid >> 6, bid = blockIdx.x, nb = gridDim.x;
    unsigned char* ws = p.ws;
    { float* cosA = (float*)(ws + OFF_COSA); float* sinA = (float*)(ws + OFF_SINA);
      for (int e = bid * 512 + tid; e < 4116 * 8; e += nb * 512) { const int pidx = e >> 3, i = e & 7; const double pos = pidx < 4112 ? (double)pidx : (double)(16384 + pidx - 4112);
          const double inv = exp(-13.122363377404328 * (2.0 * i / 16.0)); double rev = pos * inv * 0.15915494309189535; rev -= rint(rev);
          cosA[e] = __builtin_amdgcn_cosf((float)rev); sinA[e] = __builtin_amdgcn_sinf((float)rev); }
      float* cosR = (float*)(ws + OFF_COSR); float* sinR = (float*)(ws + OFF_SINR); float* cosRT = (float*)(ws + OFF_COSRT); float* sinRT = (float*)(ws + OFF_SINRT);
      for (int e = bid * 512 + tid; e < 4116 * 64; e += nb * 512) { const int pidx = e >> 6, i = e & 63; const double pos = pidx < 4112 ? (double)pidx : (double)(16384 + pidx - 4112);
          const double inv = exp(-9.210340371976182 * (2.0 * i / 128.0)); double rev = pos * inv * 0.15915494309189535; rev -= rint(rev);
          const float c = __builtin_amdgcn_cosf((float)rev), s = __builtin_amdgcn_sinf((float)rev);
          cosR[e] = c; sinR[e] = s; cosRT[i * TABP + pidx] = c; sinRT[i * TABP + pidx] = s; } }
    { bf16_t* Xn = (bf16_t*)(ws + OFF_XN);
      for (int row = bid * 8 + wid; row < MROWS; row += nb * 8) {
          bf16_t* dst = Xn + (size_t)row * DM;
          const float* src = row < ROW_S ? p.x_prompt + (size_t)row * DM : (row < ROW_M ? p.x_sample + (size_t)(row - ROW_S) * DM : (row < ROW_M + 16 ? p.meta + (size_t)(row - ROW_M) * DM : nullptr));
          if (!src) {
#pragma unroll
              for (int i = 0; i < 4; ++i) *(u32x4*)(dst + (i * 64 + lane) * 8) = (u32x4){0u, 0u, 0u, 0u};
              continue; }
          f32x4 v[8]; float ss = 0.f;
#pragma unroll
          for (int i = 0; i < 8; ++i) { v[i] = *(const f32x4*)(src + (i * 64 + lane) * 4); ss += v[i][0] * v[i][0] + v[i][1] * v[i][1] + v[i][2] * v[i][2] + v[i][3] * v[i][3]; }
#pragma unroll
          for (int o = 1; o < 64; o <<= 1) ss += __shfl_xor(ss, o);
          const float rs = rsqrtf(ss * (1.0f / 2048.0f) + 1e-6f);
#pragma unroll
          for (int i = 0; i < 8; ++i) { const f32x4 g = *(const f32x4*)(p.norm_g + (i * 64 + lane) * 4);
              u32x2 w; w.x = cvt_pk_bf16(v[i][0] * rs * g[0], v[i][1] * rs * g[1]); w.y = cvt_pk_bf16(v[i][2] * rs * g[2], v[i][3] * rs * g[3]);
              *(u32x2*)(dst + (i * 64 + lane) * 4) = w; }
      } }
    { LAS float* sT = (LAS float*)lds;
      bf16_t* WinT = (bf16_t*)(ws + OFF_WINT); bf16_t* WcatT = (bf16_t*)(ws + OFF_WCAT); bf16_t* WoT = (bf16_t*)(ws + OFF_WO);
      for (int t = bid; t < 4480; t += nb) {
          if (t < 3200) { const int kt = t / 100, ntile = t % 100; wtile(p.w_in, NIN, WinT, DM, 0, kt * 64, ntile * 128, sT, tid); }
          else if (t < 3456) { const int q = t - 3200, kt = q >> 4, ntile = q & 15; wtile(p.w_pa, DM, WcatT, KCAT, 0, kt * 64, ntile * 128, sT, tid); }
          else if (t < 3968) { const int q = t - 3456, kt = q >> 4, ntile = q & 15; wtile(p.w_pr, DM, WcatT, KCAT, 1024, kt * 64, ntile * 128, sT, tid); }
          else { const int q = t - 3968, kt = q >> 4, ntile = q & 15; wtile(p.w_o, DM, WoT, DM, 0, kt * 64, ntile * 128, sT, tid); }
      } }
}

__device__ __forceinline__ void headnorm_rope(float (&x)[64], const LAS float* gain, const float* __restrict__ cs, const float* __restrict__ sn, float scale) {
    float ss = 0.f;
#pragma unroll
    for (int d = 0; d < 64; ++d) ss += x[d] * x[d];
    const float rs = rsqrtf(ss * (1.0f / 64.0f) + 1e-6f);
#pragma unroll
    for (int d4 = 0; d4 < 16; ++d4) { const f32x4 g = *(const LAS f32x4*)(gain + d4 * 4); x[d4 * 4] *= rs * g[0]; x[d4 * 4 + 1] *= rs * g[1]; x[d4 * 4 + 2] *= rs * g[2]; x[d4 * 4 + 3] *= rs * g[3]; }
#pragma unroll
    for (int i = 0; i < 8; ++i) { const float c = cs[i], s = sn[i], x1 = x[i], x2 = x[i + 8]; x[i] = x1 * c - x2 * s; x[i + 8] = x2 * c + x1 * s; }
#pragma unroll
    for (int d = 0; d < 64; ++d) x[d] *= scale;
}
__device__ __forceinline__ void load_row64_bf16(const bf16_t* src, float (&x)[64]) {
#pragma unroll
    for (int c = 0; c < 8; ++c) { const u32x4 w = *(const u32x4*)(src + c * 8); unpack8(w, &x[c * 8]); }
}
__device__ __forceinline__ void load_row64_f32(const float* src, float (&x)[64]) {
#pragma unroll
    for (int c = 0; c < 16; ++c) { const f32x4 w = *(const f32x4*)(src + c * 4); x[c * 4] = w[0]; x[c * 4 + 1] = w[1]; x[c * 4 + 2] = w[2]; x[c * 4 + 3] = w[3]; }
}
__device__ __forceinline__ void store_row64_lds(LAS bf16_t* dst, const float (&x)[64]) {
#pragma unroll
    for (int c = 0; c < 8; ++c) *(LAS u32x4*)(dst + c * 8) = pack8(&x[c * 8]);
}
__device__ __forceinline__ void store_row64_f32(float* dst, const float (&x)[64]) {
#pragma unroll
    for (int c = 0; c < 16; ++c) *(f32x4*)(dst + c * 4) = (f32x4){x[c * 4], x[c * 4 + 1], x[c * 4 + 2], x[c * 4 + 3]};
}
template <int NKT, class MaskF>
__device__ __forceinline__ void attn_tile16(const LAS bf16_t* sQ, int qp, const LAS bf16_t* sK, int kp, const LAS bf16_t* sVt, int vp, float sinkv, MaskF mask, f32x4 (&o)[4], int lane) {
    const int fr = lane & 15, fq = lane >> 4;
    bf16x8 qf[2];
#pragma unroll
    for (int ks = 0; ks < 2; ++ks) qf[ks] = *(const LAS bf16x8*)(sQ + fr * qp + ks * 32 + fq * 8);
    f32x4 s[NKT];
#pragma unroll
    for (int kt = 0; kt < NKT; ++kt) { s[kt] = (f32x4){0.f, 0.f, 0.f, 0.f};
#pragma unroll
        for (int ks = 0; ks < 2; ++ks) { const bf16x8 kf = *(const LAS bf16x8*)(sK + (kt * 16 + fr) * kp + ks * 32 + fq * 8); s[kt] = __builtin_amdgcn_mfma_f32_16x16x32_bf16(kf, qf[ks], s[kt], 0, 0, 0); } }
    float mx = sinkv;
#pragma unroll
    for (int kt = 0; kt < NKT; ++kt)
#pragma unroll
        for (int r = 0; r < 4; ++r) { const float v = mask(kt * 16 + fq * 4 + r) ? s[kt][r] : -1e30f; s[kt][r] = v; mx = fmaxf(mx, v); }
    mx = fmaxf(mx, __shfl_xor(mx, 16)); mx = fmaxf(mx, __shfl_xor(mx, 32));
    float sum = 0.f;
#pragma unroll
    for (int kt = 0; kt < NKT; ++kt)
#pragma unroll
        for (int r = 0; r < 4; ++r) { const float pe = fast_exp(s[kt][r] - mx); s[kt][r] = pe; sum += pe; }
    sum += __shfl_xor(sum, 16); sum += __shfl_xor(sum, 32);
    sum += fast_exp(sinkv - mx);
    const float inv = 1.0f / sum;
#pragma unroll
    for (int dt = 0; dt < 4; ++dt) o[dt] = (f32x4){0.f, 0.f, 0.f, 0.f};
#pragma unroll
    for (int k2 = 0; k2 < NKT / 2; ++k2) {
        u32x4 pw; pw.x = cvt_pk_bf16(s[2 * k2][0], s[2 * k2][1]); pw.y = cvt_pk_bf16(s[2 * k2][2], s[2 * k2][3]); pw.z = cvt_pk_bf16(s[2 * k2 + 1][0], s[2 * k2 + 1][1]); pw.w = cvt_pk_bf16(s[2 * k2 + 1][2], s[2 * k2 + 1][3]);
        const bf16x8 pf = __builtin_bit_cast(bf16x8, pw);
#pragma unroll
        for (int dt = 0; dt < 4; ++dt) { const LAS bf16_t* vr = sVt + (dt * 16 + fr) * vp + k2 * 32 + fq * 4;
            const u32x2 lo = *(const LAS u32x2*)vr, hi = *(const LAS u32x2*)(vr + 16);
            const u32x4 vw = (u32x4){lo.x, lo.y, hi.x, hi.y};
            o[dt] = __builtin_amdgcn_mfma_f32_16x16x32_bf16(__builtin_bit_cast(bf16x8, vw), pf, o[dt], 0, 0, 0); }
    }
#pragma unroll
    for (int dt = 0; dt < 4; ++dt) o[dt] *= inv;
}

__device__ void attn_prompt_item(const Params& p, LAS unsigned char* lds, int item) {
    int tid_ = threadIdx.x; asm volatile("" : "+v"(tid_)); const int tid = tid_, lane = tid & 63, wid = tid >> 6;
    const int kvh = item & 3, blk = (item >> 2) & 31, b = item >> 7;
    const bf16_t* U = (const bf16_t*)(p.ws + OFF_U); const bf16_t* UT = (const bf16_t*)(p.ws + OFF_UT); bf16_t* Acat = (bf16_t*)(p.ws + OFF_ACAT);
    const float* cosA = (const float*)(p.ws + OFF_COSA); const float* sinA = (const float*)(p.ws + OFF_SINA);
    constexpr int QP = 72, KP = 72, VP = 296;
    LAS bf16_t* sQ = (LAS bf16_t*)lds; LAS bf16_t* sK = sQ + 512 * QP; LAS bf16_t* sVt = sK + 288 * KP; LAS float* sG = (LAS float*)(sVt + 64 * VP);
    const int tok0 = blk * 128;
    if (tid < 128) sG[tid] = tid < 64 ? p.q_g[tid] : p.k_g[tid - 64];
    __syncthreads();
    {
        const int g = tid >> 7, tok = tid & 127; const int row = b * 4096 + tok0 + tok; const int pidx = 16 + tok0 + tok;
        float x[64]; load_row64_bf16(U + (size_t)row * NIN + C_QA + (kvh * 4 + g) * 64, x);
        headnorm_rope(x, sG, cosA + pidx * 8, sinA + pidx * 8, 0.125f);
        store_row64_lds(sQ + tid * QP, x);
    }
    __builtin_amdgcn_sched_barrier(0);
    if (tid < 288) {
        float x[64];
        int row = -1, pidx = 0;
        if (tid < 16) { row = ROW_M + tid; pidx = tid; }
        else if (tid < 272) { const int tk = tok0 - 128 + (tid - 16); if (tk >= 0) { row = b * 4096 + tk; pidx = 16 + tk; } }
        if (row >= 0) { load_row64_bf16(U + (size_t)row * NIN + C_KA + kvh * 64, x); headnorm_rope(x, sG + 64, cosA + pidx * 8, sinA + pidx * 8, 1.0f); }
        else {
#pragma unroll
            for (int d = 0; d < 64; ++d) x[d] = 0.f; }
        store_row64_lds(sK + tid * KP, x);
        if (blk == 31 && tid >= 144 && tid < 272) store_row64_f32(p.out + O_WKP + ((size_t)(b * 128 + (tid - 144)) * 4 + kvh) * 64, x);
    }
    for (int c = tid; c < 64 * 37; c += 512) { const int d = c / 37, ch = c % 37; u32x4 w = (u32x4){0u, 0u, 0u, 0u};
        const bf16_t* src = UT + (size_t)(UT_VA + kvh * 64 + d) * UTP;
        if (ch < 2) w = *(const u32x4*)(src + ROW_M + ch * 8);
        else if (ch < 34) { const int tk = tok0 - 128 + (ch - 2) * 8; if (tk >= 0) w = *(const u32x4*)(src + b * 4096 + tk); }
        *(LAS u32x4*)(sVt + d * VP + ch * 8) = w; }
    if (blk == 31) for (int e = tid; e < 128 * 64; e += 512) { const int tk = e >> 6, d = e & 63;
        p.out[O_WVP + ((size_t)(b * 128 + tk) * 4 + kvh) * 64 + d] = bf2f(U[(size_t)(b * 4096 + 3968 + tk) * NIN + C_VA + kvh * 64 + d]); }
    __syncthreads();
    const int g = wid >> 1, half = wid & 1, fr = lane & 15, fq = lane >> 4;
    const float sinkv = p.sinks[kvh * 4 + g];
#pragma unroll 1
    for (int mt_ = 0; mt_ < 4; ++mt_) {
        int mt = mt_; asm volatile("" : "+s"(mt));
        const int qi = half * 64 + mt * 16 + fr;
        f32x4 o[4];
        auto mask = [&](int kidx) -> bool { const int kj = kidx - 144; return kidx < 16 || (kidx < 272 && kj <= qi && kj > qi - 128 && tok0 + kj >= 0); };
        const size_t row = (size_t)(b * 4096 + tok0 + qi); const int hc = (kvh * 4 + g) * 64;
        u32x2 zq[4];
#pragma unroll
        for (int dt = 0; dt < 4; ++dt) zq[dt] = *(const u32x2*)(U + row * NIN + C_ZA + hc + dt * 16 + fq * 4);
        attn_tile16<18>(sQ + (g * 128 + half * 64 + mt * 16) * QP, QP, sK, KP, sVt, VP, sinkv, mask, o, lane);
#pragma unroll
        for (int dt = 0; dt < 4; ++dt) { const int d = dt * 16 + fq * 4;
            const u32x2 zw = zq[dt];
            u32x2 w; w.x = cvt_pk_bf16(o[dt][0] * siluf_(bf_lo(zw.x)), o[dt][1] * siluf_(bf_hi(zw.x))); w.y = cvt_pk_bf16(o[dt][2] * siluf_(bf_lo(zw.y)), o[dt][3] * siluf_(bf_hi(zw.y)));
            *(u32x2*)(Acat + row * KCAT + hc + d) = w; }
    }
    __syncthreads();
}

__device__ void attn_sample_item(const Params& p, LAS unsigned char* lds, int item) {
    int tid_ = threadIdx.x; asm volatile("" : "+v"(tid_)); const int tid = tid_, lane = tid & 63, wid = tid >> 6;
    const int kvh = item & 3, bs = item >> 2;
    const bf16_t* U = (const bf16_t*)(p.ws + OFF_U); const bf16_t* UT = (const bf16_t*)(p.ws + OFF_UT); bf16_t* Acat = (bf16_t*)(p.ws + OFF_ACAT);
    const float* cosA = (const float*)(p.ws + OFF_COSA); const float* sinA = (const float*)(p.ws + OFF_SINA);
    constexpr int QP = 72, KP = 72, VP = 168;
    LAS bf16_t* sQ = (LAS bf16_t*)lds; LAS bf16_t* sK = sQ + 16 * QP; LAS bf16_t* sVt = sK + 160 * KP; LAS float* sG = (LAS float*)(sVt + 64 * VP);
    if (tid < 128) sG[tid] = tid < 64 ? p.q_g[tid] : p.k_g[tid - 64];
    __syncthreads();
    if (tid < 160) {
        float x[64];
        if (tid < 16) { load_row64_bf16(U + (size_t)(ROW_M + tid) * NIN + C_KA + kvh * 64, x); headnorm_rope(x, sG + 64, cosA + tid * 8, sinA + tid * 8, 1.0f); }
        else if (tid < 144) { const int c = tid - 16; load_row64_f32(p.cache_k + ((size_t)(bs * 128 + c) * 4 + kvh) * 64, x);
            if (c >= 4) store_row64_f32(p.out + O_WKS + ((size_t)(bs * 128 + c - 4) * 4 + kvh) * 64, x); }
        else if (tid < 148) { const int i = tid - 144; load_row64_bf16(U + (size_t)(ROW_S + bs * 4 + i) * NIN + C_KA + kvh * 64, x);
            headnorm_rope(x, sG + 64, cosA + (4112 + i) * 8, sinA + (4112 + i) * 8, 1.0f);
            store_row64_f32(p.out + O_WKS + ((size_t)(bs * 128 + 124 + i) * 4 + kvh) * 64, x); }
        else {
#pragma unroll
            for (int d = 0; d < 64; ++d) x[d] = 0.f; }
        store_row64_lds(sK + tid * KP, x);
    } else if (tid >= 192 && tid < 208) {
        const int r = tid - 192, g = r >> 2, i = r & 3;
        float x[64]; load_row64_bf16(U + (size_t)(ROW_S + bs * 4 + i) * NIN + C_QA + (kvh * 4 + g) * 64, x);
        headnorm_rope(x, sG, cosA + (4112 + i) * 8, sinA + (4112 + i) * 8, 0.125f);
        store_row64_lds(sQ + r * QP, x);
    }
    for (int e = tid; e < 168 * 64; e += 512) { const int d = e & 63, key = e >> 6; float v = 0.f;
        if (key < 16) v = bf2f(UT[(size_t)(UT_VA + kvh * 64 + d) * UTP + ROW_M + key]);
        else if (key < 144) { const int c = key - 16; v = p.cache_v[((size_t)(bs * 128 + c) * 4 + kvh) * 64 + d]; if (c >= 4) p.out[O_WVS + ((size_t)(bs * 128 + c - 4) * 4 + kvh) * 64 + d] = v; }
        else if (key < 148) { const int i = key - 144; v = bf2f(U[(size_t)(ROW_S + bs * 4 + i) * NIN + C_VA + kvh * 64 + d]); p.out[O_WVS + ((size_t)(bs * 128 + 124 + i) * 4 + kvh) * 64 + d] = v; }
        sVt[d * VP + key] = f2bf(v); }
    __syncthreads();
    if (wid == 0) {
        const int fr = lane & 15, fq = lane >> 4, g = fr >> 2, i = fr & 3;
        const float sinkv = p.sinks[kvh * 4 + g];
        f32x4 o[4];
        auto mask = [&](int kidx) -> bool { return kidx < 16 || (kidx < 144 ? (kidx - 16) > i : (kidx < 148 && (kidx - 144) <= i)); };
        attn_tile16<10>(sQ, QP, sK, KP, sVt, VP, sinkv, mask, o, lane);
        const size_t row = (size_t)(ROW_S + bs * 4 + i); const int hc = (kvh * 4 + g) * 64;
        u32x2 zq[4];
#pragma unroll
        for (int dt = 0; dt < 4; ++dt) zq[dt] = *(const u32x2*)(U + row * NIN + C_ZA + hc + dt * 16 + fq * 4);
#pragma unroll
        for (int dt = 0; dt < 4; ++dt) { const int d = dt * 16 + fq * 4;
            const u32x2 zw = zq[dt];
            u32x2 w; w.x = cvt_pk_bf16(o[dt][0] * siluf_(bf_lo(zw.x)), o[dt][1] * siluf_(bf_hi(zw.x))); w.y = cvt_pk_bf16(o[dt][2] * siluf_(bf_lo(zw.y)), o[dt][3] * siluf_(bf_hi(zw.y)));
            *(u32x2*)(Acat + row * KCAT + hc + d) = w; }
    }
    __syncthreads();
}

__device__ void ret_chunk_item(const Params& p, LAS unsigned char* lds, int item) {
    int tid_ = threadIdx.x; asm volatile("" : "+v"(tid_)); const int tid = tid_, lane = tid & 63, wid = tid >> 6, fr = lane & 15, fq = lane >> 4;
    const bf16_t* UT = (const bf16_t*)(p.ws + OFF_UT);
    const float* cosRT = (const float*)(p.ws + OFF_COSRT); const float* sinRT = (const float*)(p.ws + OFF_SINRT);
    int h, tokrow0, pidx0, C, nks; float* dst;
    if (item < 512) { h = item & 7; const int c = (item >> 3) & 31, b = item >> 8; tokrow0 = b * 4096 + c * 128; pidx0 = 16 + c * 128; C = 128; nks = 4; dst = (float*)(p.ws + OFF_UCT) + (size_t)item * 32768; }
    else { h = item - 512; tokrow0 = ROW_M; pidx0 = 0; C = 16; nks = 1; dst = (float*)(p.ws + OFF_SMT) + (size_t)h * 32768; }
    const int ntok = nks * 32;
    constexpr int TP = 136;
    LAS bf16_t* sKt = (LAS bf16_t*)lds; LAS bf16_t* sVt = sKt + 128 * TP;
    const float lg2 = lg2_of(h);
    const int nch = ntok >> 3;
    for (int t = tid; t < 64 * nch; t += 512) { const int i = t / nch, ch = t % nch;
        const bf16_t* s1 = UT + (size_t)(UT_KR + h * 128 + i) * UTP + tokrow0 + ch * 8;
        const u32x4 wa = *(const u32x4*)s1, wb = *(const u32x4*)(s1 + (size_t)64 * UTP);
        float a[8], bb[8], cs[8], sn[8], o1[8], o2[8]; unpack8(wa, a); unpack8(wb, bb);
        const float* cp = cosRT + i * TABP + pidx0 + ch * 8; const float* sp = sinRT + i * TABP + pidx0 + ch * 8;
        const f32x4 c0 = *(const f32x4*)cp, c1 = *(const f32x4*)(cp + 4), s0 = *(const f32x4*)sp, s1v = *(const f32x4*)(sp + 4);
        cs[0] = c0[0]; cs[1] = c0[1]; cs[2] = c0[2]; cs[3] = c0[3]; cs[4] = c1[0]; cs[5] = c1[1]; cs[6] = c1[2]; cs[7] = c1[3];
        sn[0] = s0[0]; sn[1] = s0[1]; sn[2] = s0[2]; sn[3] = s0[3]; sn[4] = s1v[0]; sn[5] = s1v[1]; sn[6] = s1v[2]; sn[7] = s1v[3];
#pragma unroll
        for (int e = 0; e < 8; ++e) { const int j = ch * 8 + e; const float w = j < C ? 0.08838834764831845f * __builtin_amdgcn_exp2f((float)(C - 1 - j) * lg2) : 0.f;
            o1[e] = (a[e] * cs[e] - bb[e] * sn[e]) * w; o2[e] = (bb[e] * cs[e] + a[e] * sn[e]) * w; }
        *(LAS u32x4*)(sKt + i * TP + ch * 8) = pack8(o1); *(LAS u32x4*)(sKt + (i + 64) * TP + ch * 8) = pack8(o2); }
    for (int t = tid; t < 256 * nch; t += 512) { const int dv = t / nch, ch = t % nch;
        *(LAS u32x4*)(sVt + dv * TP + ch * 8) = *(const u32x4*)(UT + (size_t)(UT_VR + h * 256 + dv) * UTP + tokrow0 + ch * 8); }
    __syncthreads();
    {
        bf16x8 af[4];
#pragma unroll
        for (int ks = 0; ks < 4; ++ks) af[ks] = ks < nks ? *(const LAS bf16x8*)(sKt + (wid * 16 + fr) * TP + ks * 32 + fq * 8) : (bf16x8){0, 0, 0, 0, 0, 0, 0, 0};
#pragma unroll 4
        for (int nt = 0; nt < 16; ++nt) { f32x4 acc = (f32x4){0.f, 0.f, 0.f, 0.f};
#pragma unroll
            for (int ks = 0; ks < 4; ++ks) if (ks < nks) { const bf16x8 bf = *(const LAS bf16x8*)(sVt + (nt * 16 + fr) * TP + ks * 32 + fq * 8); acc = __builtin_amdgcn_mfma_f32_16x16x32_bf16(af[ks], bf, acc, 0, 0, 0); }
            *(f32x4*)(dst + (size_t)(nt * 16 + fr) * 128 + wid * 16 + fq * 4) = acc; }
    }
    __syncthreads();
}

__device__ void ret_sample_item(const Params& p, LAS unsigned char* lds, int item) {
    int tid_ = threadIdx.x; asm volatile("" : "+v"(tid_)); const int tid = tid_, lane = tid & 63, wid = tid >> 6;
    const int h = item & 7, bs = item >> 3;
    const bf16_t* U = (const bf16_t*)(p.ws + OFF_U); bf16_t* Acat = (bf16_t*)(p.ws + OFF_ACAT);
    const float* cosR = (const float*)(p.ws + OFF_COSR); const float* sinR = (const float*)(p.ws + OFF_SINR);
    LAS float* sq = (LAS float*)lds;
    LAS float* sk = sq + 512;
    LAS float* sv = sk + 512;
    LAS float* sdot = sv + 1024;
    LAS float* sred = sdot + 16;
    LAS float* red = sred + 48;
    const float lg2 = lg2_of(h);
    const int dv4 = lane * 4;
    const size_t sbase = ((size_t)(bs * 8 + h) * 128 + wid * 16) * 256 + dv4;
    const float* Sp = p.state + sbase; float* So = p.out + O_RS + sbase;
    f32x4 S[16];
#pragma unroll
    for (int e = 0; e < 16; ++e) S[e] = __builtin_nontemporal_load((const f32x4*)(Sp + (size_t)e * 256));
    {
        const int which = tid >> 8, i = (tid >> 6) & 3, dd = tid & 63;
        const bf16_t* src = U + (size_t)(ROW_S + bs * 4 + i) * NIN + (which ? C_KR : C_QR) + h * 128;
        const float x1 = bf2f(src[dd]), x2 = bf2f(src[dd + 64]);
        const float c = cosR[(4112 + i) * 64 + dd], s = sinR[(4112 + i) * 64 + dd];
        const float sc = which ? 0.08838834764831845f : 1.0f;
        LAS float* d = (which ? sk : sq) + i * 128;
        d[dd] = (x1 * c - x2 * s) * sc; d[dd + 64] = (x2 * c + x1 * s) * sc;
        for (int e = tid; e < 1024; e += 512) { const int ii = e >> 8, dv = e & 255; sv[e] = bf2f(U[(size_t)(ROW_S + bs * 4 + ii) * NIN + C_VR + h * 256 + dv]); }
    }
    __syncthreads();
    {
        const int gi = tid >> 5, l32 = tid & 31, i = gi >> 2, j = gi & 3;
        float s = 0.f;
#pragma unroll
        for (int m = 0; m < 4; ++m) s += sq[i * 128 + l32 + 32 * m] * sk[j * 128 + l32 + 32 * m];
#pragma unroll
        for (int o = 1; o < 32; o <<= 1) s += __shfl_xor(s, o);
        if (l32 == 0) sdot[gi] = s;
    }
    f32x4 vj[4];
#pragma unroll
    for (int j = 0; j < 4; ++j) vj[j] = *(const LAS f32x4*)(sv + j * 256 + dv4);
    const float g1 = __builtin_amdgcn_exp2f(lg2), g2 = g1 * g1, g3 = g2 * g1, g4 = g2 * g2;
    f32x4 qS[4];
#pragma unroll
    for (int i = 0; i < 4; ++i) qS[i] = (f32x4){0.f, 0.f, 0.f, 0.f};
#pragma unroll
    for (int e = 0; e < 16; ++e) { const int dk = wid * 16 + e;
#pragma unroll
        for (int i = 0; i < 4; ++i) qS[i] += sq[i * 128 + dk] * S[e];
        const f32x4 sn = g4 * S[e] + (g3 * sk[dk]) * vj[0] + (g2 * sk[128 + dk]) * vj[1] + (g1 * sk[256 + dk]) * vj[2] + sk[384 + dk] * vj[3];
        __builtin_nontemporal_store(sn, (f32x4*)(So + (size_t)e * 256)); }
#pragma unroll
    for (int i = 0; i < 4; ++i) *(LAS f32x4*)(red + (wid * 4 + i) * 256 + dv4) = qS[i];
    __syncthreads();
    const int i = tid >> 7, dv2 = (tid & 127) * 2;
    float o0 = 0.f, o1 = 0.f;
#pragma unroll
    for (int w = 0; w < 8; ++w) { o0 += red[(w * 4 + i) * 256 + dv2]; o1 += red[(w * 4 + i) * 256 + dv2 + 1]; }
    const float gi1 = __builtin_amdgcn_exp2f((float)(i + 1) * lg2);
    o0 *= gi1; o1 *= gi1;
#pragma unroll
    for (int j = 0; j < 4; ++j) if (j <= i) { const float cf = sdot[i * 4 + j] * __builtin_amdgcn_exp2f((float)(i - j) * lg2); o0 += cf * sv[j * 256 + dv2]; o1 += cf * sv[j * 256 + dv2 + 1]; }
    float s = o0 + o1;
#pragma unroll
    for (int o = 1; o < 64; o <<= 1) s += __shfl_xor(s, o);
    if (lane == 0) sred[wid] = s;
    __syncthreads();
    const float mean = (sred[2 * i] + sred[2 * i + 1]) * (1.0f / 256.0f);
    const float d0 = o0 - mean, d1 = o1 - mean;
    float q = d0 * d0 + d1 * d1;
#pragma unroll
    for (int o = 1; o < 64; o <<= 1) q += __shfl_xor(q, o);
    if (lane == 0) sred[8 + wid] = q;
    __syncthreads();
    const float var = (sred[8 + 2 * i] + sred[8 + 2 * i + 1]) * (1.0f / 256.0f);
    const float rstd = rsqrtf(var + 1e-5f);
    const size_t row = (size_t)(ROW_S + bs * 4 + i); const int cc = h * 256 + dv2;
    const unsigned zw = *(const unsigned*)(U + row * NIN + C_ZR + cc);
    const float y0 = (d0 * rstd * p.gn_g[cc] + p.gn_b[cc]) * siluf_(bf_lo(zw)), y1 = (d1 * rstd * p.gn_g[cc + 1] + p.gn_b[cc + 1]) * siluf_(bf_hi(zw));
    *(unsigned*)(Acat + row * KCAT + 1024 + cc) = cvt_pk_bf16(y0, y1);
    __syncthreads();
}

__device__ void phase3_scan(const Params& p) {
    const int gt = blockIdx.x * 512 + threadIdx.x;
    if (gt >= 131072) return;
    const int b = gt >> 16, h = (gt >> 13) & 7, rem = gt & 8191;
    const float* UcT = (const float*)(p.ws + OFF_UCT); const float* SmT = (const float*)(p.ws + OFF_SMT); bf16_t* SpT = (bf16_t*)(p.ws + OFF_SPT);
    const float g128 = __builtin_amdgcn_exp2f(128.0f * lg2_of(h));
    f32x4 S = *(const f32x4*)(SmT + (size_t)h * 32768 + rem * 4);
    const size_t off0 = ((size_t)(b * 32 * 8 + h)) * 32768 + rem * 4;
    f32x4 ua[8], ub[8];
#pragma unroll
    for (int k = 0; k < 8; ++k) ua[k] = *(const f32x4*)(UcT + off0 + (size_t)k * 262144);
#pragma unroll
    for (int k = 0; k < 8; ++k) ub[k] = *(const f32x4*)(UcT + off0 + (size_t)(8 + k) * 262144);
#pragma unroll
    for (int k = 0; k < 8; ++k) { u32x2 w; w.x = cvt_pk_bf16(S[0], S[1]); w.y = cvt_pk_bf16(S[2], S[3]); *(u32x2*)(SpT + off0 + (size_t)k * 262144) = w; S = g128 * S + ua[k]; }
#pragma unroll
    for (int k = 0; k < 8; ++k) ua[k] = *(const f32x4*)(UcT + off0 + (size_t)(16 + k) * 262144);
#pragma unroll
    for (int k = 0; k < 8; ++k) { u32x2 w; w.x = cvt_pk_bf16(S[0], S[1]); w.y = cvt_pk_bf16(S[2], S[3]); *(u32x2*)(SpT + off0 + (size_t)(8 + k) * 262144) = w; S = g128 * S + ub[k]; }
#pragma unroll
    for (int k = 0; k < 8; ++k) ub[k] = *(const f32x4*)(UcT + off0 + (size_t)(24 + k) * 262144);
#pragma unroll
    for (int k = 0; k < 8; ++k) { u32x2 w; w.x = cvt_pk_bf16(S[0], S[1]); w.y = cvt_pk_bf16(S[2], S[3]); *(u32x2*)(SpT + off0 + (size_t)(16 + k) * 262144) = w; S = g128 * S + ua[k]; }
#pragma unroll
    for (int k = 0; k < 8; ++k) { u32x2 w; w.x = cvt_pk_bf16(S[0], S[1]); w.y = cvt_pk_bf16(S[2], S[3]); *(u32x2*)(SpT + off0 + (size_t)(24 + k) * 262144) = w; S = g128 * S + ub[k]; }
    const int dv = rem >> 5, dk = (rem & 31) * 4;
    float* o = p.out + O_RP + ((size_t)(b * 8 + h) * 128 + dk) * 256 + dv;
    o[0] = S[0]; o[256] = S[1]; o[512] = S[2]; o[768] = S[3];
}

__device__ void ret_out_item(const Params& p, LAS unsigned char* lds, int item) {
    int tid_ = threadIdx.x; asm volatile("" : "+v"(tid_)); const int tid = tid_, lane = tid & 63, wid = tid >> 6, fr = lane & 15, fq = lane >> 4;
    const int h = item & 7, c = (item >> 3) & 31, b = item >> 8;
    const bf16_t* U = (const bf16_t*)(p.ws + OFF_U); const bf16_t* UT = (const bf16_t*)(p.ws + OFF_UT); bf16_t* Acat = (bf16_t*)(p.ws + OFF_ACAT);
    const bf16_t* SpT = (const bf16_t*)(p.ws + OFF_SPT) + (size_t)item * 32768;
    const float* cosR = (const float*)(p.ws + OFF_COSR); const float* sinR = (const float*)(p.ws + OFF_SINR);
    constexpr int TP = 136;
    LAS bf16_t* sK = (LAS bf16_t*)lds; LAS bf16_t* sX = sK + 128 * TP; LAS float* sGN = (LAS float*)(sX + 256 * TP);
    const int tokrow0 = b * 4096 + c * 128, pidx0 = 16 + c * 128;
    sGN[tid] = tid < 256 ? p.gn_g[h * 256 + tid] : p.gn_b[h * 256 + tid - 256];
    const float lg2 = lg2_of(h);
    bf16x8 qf[4];
    { const int i = wid * 16 + fr; const bf16_t* src = U + (size_t)(tokrow0 + i) * NIN + C_QR + h * 128 + fq * 8;
      float x[4][8];
#pragma unroll
      for (int ks = 0; ks < 4; ++ks) { const u32x4 w = *(const u32x4*)(src + ks * 32); unpack8(w, x[ks]); }
#pragma unroll
      for (int ks = 0; ks < 2; ++ks) { const float* cp = cosR + (size_t)(pidx0 + i) * 64 + ks * 32 + fq * 8; const float* sp = sinR + (size_t)(pidx0 + i) * 64 + ks * 32 + fq * 8;
          const f32x4 c0 = *(const f32x4*)cp, c1 = *(const f32x4*)(cp + 4), s0 = *(const f32x4*)sp, s1 = *(const f32x4*)(sp + 4);
#pragma unroll
          for (int e = 0; e < 8; ++e) { const float cs = e < 4 ? c0[e & 3] : c1[e & 3], sn = e < 4 ? s0[e & 3] : s1[e & 3]; const float x1 = x[ks][e], x2 = x[ks + 2][e];
              x[ks][e] = x1 * cs - x2 * sn; x[ks + 2][e] = x2 * cs + x1 * sn; } }
#pragma unroll
      for (int ks = 0; ks < 4; ++ks) qf[ks] = __builtin_bit_cast(bf16x8, pack8(x[ks])); }
    for (int t = tid; t < 1024; t += 512) { const int j = t >> 3, ch = t & 7;
        const bf16_t* src = U + (size_t)(tokrow0 + j) * NIN + C_KR + h * 128 + ch * 8;
        const u32x4 wa = *(const u32x4*)src, wb = *(const u32x4*)(src + 64);
        float a[8], bb[8], o1[8], o2[8]; unpack8(wa, a); unpack8(wb, bb);
        const float* cp = cosR + (size_t)(pidx0 + j) * 64 + ch * 8; const float* sp = sinR + (size_t)(pidx0 + j) * 64 + ch * 8;
        const f32x4 c0 = *(const f32x4*)cp, c1 = *(const f32x4*)(cp + 4), s0 = *(const f32x4*)sp, s1 = *(const f32x4*)(sp + 4);
#pragma unroll
        for (int e = 0; e < 8; ++e) { const float cs = e < 4 ? c0[e & 3] : c1[e & 3], sn = e < 4 ? s0[e & 3] : s1[e & 3];
            o1[e] = (a[e] * cs - bb[e] * sn) * 0.08838834764831845f; o2[e] = (bb[e] * cs + a[e] * sn) * 0.08838834764831845f; }
        *(LAS u32x4*)(sK + j * TP + ch * 8) = pack8(o1); *(LAS u32x4*)(sK + j * TP + 64 + ch * 8) = pack8(o2); }
    for (int t = tid; t < 4096; t += 512) { const int dv = t >> 4, ch = t & 15;
        *(LAS u32x4*)(sX + dv * TP + ch * 8) = *(const u32x4*)(UT + (size_t)(UT_VR + h * 256 + dv) * UTP + tokrow0 + ch * 8); }
    __syncthreads();
    const int iq = wid * 16 + fr;
    bf16x8 pf[4];
#pragma unroll
    for (int k2 = 0; k2 < 4; ++k2) {
        u32x4 pw = (u32x4){0u, 0u, 0u, 0u};
        if (2 * k2 <= wid) {
            f32x4 s0 = (f32x4){0.f, 0.f, 0.f, 0.f}, s1 = (f32x4){0.f, 0.f, 0.f, 0.f};
#pragma unroll
            for (int ks = 0; ks < 4; ++ks) { const bf16x8 k0 = *(const LAS bf16x8*)(sK + (k2 * 32 + fr) * TP + ks * 32 + fq * 8), k1 = *(const LAS bf16x8*)(sK + (k2 * 32 + 16 + fr) * TP + ks * 32 + fq * 8);
                s0 = __builtin_amdgcn_mfma_f32_16x16x32_bf16(k0, qf[ks], s0, 0, 0, 0); s1 = __builtin_amdgcn_mfma_f32_16x16x32_bf16(k1, qf[ks], s1, 0, 0, 0); }
            float v[8];
#pragma unroll
            for (int r = 0; r < 4; ++r) { const int j0 = k2 * 32 + fq * 4 + r, j1 = j0 + 16;
                v[r] = j0 <= iq ? s0[r] * __builtin_amdgcn_exp2f(-(float)(j0 + 1) * lg2) : 0.f; v[4 + r] = j1 <= iq ? s1[r] * __builtin_amdgcn_exp2f(-(float)(j1 + 1) * lg2) : 0.f; }
            pw = pack8(v);
        }
        pf[k2] = __builtin_bit_cast(bf16x8, pw);
    }
    f32x4 o[16];
#pragma unroll
    for (int dt = 0; dt < 16; ++dt) { o[dt] = (f32x4){0.f, 0.f, 0.f, 0.f};
#pragma unroll
        for (int k2 = 0; k2 < 4; ++k2) if (2 * k2 <= wid) { const LAS bf16_t* vr = sX + (dt * 16 + fr) * TP + k2 * 32 + fq * 4;
            const u32x2 lo = *(const LAS u32x2*)vr, hi = *(const LAS u32x2*)(vr + 16); const u32x4 vw = (u32x4){lo.x, lo.y, hi.x, hi.y};
            o[dt] = __builtin_amdgcn_mfma_f32_16x16x32_bf16(__builtin_bit_cast(bf16x8, vw), pf[k2], o[dt], 0, 0, 0); } }
    __syncthreads();
    for (int t = tid; t < 4096; t += 512) { const int dv = t >> 4, ch = t & 15; *(LAS u32x4*)(sX + dv * TP + ch * 8) = *(const u32x4*)(SpT + (size_t)dv * 128 + ch * 8); }
    __syncthreads();
    const size_t row = (size_t)(tokrow0 + iq);
    u32x2 zr[16];
#pragma unroll
    for (int dt = 0; dt < 16; ++dt) zr[dt] = *(const u32x2*)(U + row * NIN + C_ZR + h * 256 + dt * 16 + fq * 4);
#pragma unroll
    for (int dt = 0; dt < 16; ++dt)
#pragma unroll
        for (int ks = 0; ks < 4; ++ks) { const bf16x8 sf = *(const LAS bf16x8*)(sX + (dt * 16 + fr) * TP + ks * 32 + fq * 8); o[dt] = __builtin_amdgcn_mfma_f32_16x16x32_bf16(sf, qf[ks], o[dt], 0, 0, 0); }
    const float gi1 = __builtin_amdgcn_exp2f((float)(iq + 1) * lg2);
    float sum = 0.f;
#pragma unroll
    for (int dt = 0; dt < 16; ++dt) { o[dt] *= gi1; sum += (o[dt][0] + o[dt][1]) + (o[dt][2] + o[dt][3]); }
    sum += __shfl_xor(sum, 16); sum += __shfl_xor(sum, 32);
    const float mean = sum * (1.0f / 256.0f);
    float q = 0.f;
#pragma unroll
    for (int dt = 0; dt < 16; ++dt) { o[dt] -= mean; q += (o[dt][0] * o[dt][0] + o[dt][1] * o[dt][1]) + (o[dt][2] * o[dt][2] + o[dt][3] * o[dt][3]); }
    q += __shfl_xor(q, 16); q += __shfl_xor(q, 32);
    const float rstd = rsqrtf(q * (1.0f / 256.0f) + 1e-5f);
#pragma unroll
    for (int dt = 0; dt < 16; ++dt) { const int cc = h * 256 + dt * 16 + fq * 4;
        const f32x4 gg = *(const LAS f32x4*)(sGN + dt * 16 + fq * 4), gb = *(const LAS f32x4*)(sGN + 256 + dt * 16 + fq * 4);
        const u32x2 zw = zr[dt];
        const float y0 = (o[dt][0] * rstd * gg[0] + gb[0]) * siluf_(bf_lo(zw.x)), y1 = (o[dt][1] * rstd * gg[1] + gb[1]) * siluf_(bf_hi(zw.x));
        const float y2 = (o[dt][2] * rstd * gg[2] + gb[2]) * siluf_(bf_lo(zw.y)), y3 = (o[dt][3] * rstd * gg[3] + gb[3]) * siluf_(bf_hi(zw.y));
        u32x2 w; w.x = cvt_pk_bf16(y0, y1); w.y = cvt_pk_bf16(y2, y3);
        *(u32x2*)(Acat + row * KCAT + 1024 + cc) = w; }
    __syncthreads();
}

__global__ void __launch_bounds__(512, 2) mega(Params p) {
    extern __shared__ __attribute__((aligned(16))) unsigned char shm[];
    LAS unsigned char* lds = (LAS unsigned char*)shm;
    cg::grid_group grid = cg::this_grid();
    const int bid = blockIdx.x, nb = gridDim.x;
    unsigned char* ws = p.ws;
#ifndef REP
#define REP 0
#endif
#define PH(n) ((n) >= p.ph_lo && (n) < p.ph_hi)
#define SEAM(n) do { if ((n) + 1 > p.ph_lo && (n) + 1 < p.ph_hi) grid.sync(); } while (0)
#define REPS(n) for (int rep_ = 0; rep_ <= ((REP >> (n)) & 1); ++rep_)
#define RSYNC do { if (rep_) grid.sync(); } while (0)
    if (PH(0)) REPS(0) { RSYNC; phase0(p, lds); }
    SEAM(0);
    if (PH(1)) REPS(1) { RSYNC; pg8::Gemm g{(const bf16_t*)(ws + OFF_XN), (const bf16_t*)(ws + OFF_WINT), MROWS, NIN, DM}; pg8::StaticOrder S; S.init(g.M, g.N, nb, bid);
        EpiU E{(bf16_t*)(ws + OFF_U), (bf16_t*)(ws + OFF_UT)}; pg8::gemm_phase<EpiU>(lds, g, S, E); }
    SEAM(1);
    if (PH(2)) REPS(2) { RSYNC;
        const int n_my = (2312 - bid + nb - 1) / nb;
        for (int k = 0; k < n_my; ++k) { const int it = bid + nb * ((bid & 1) ? n_my - 1 - k : k);
            if (it < 256) attn_prompt_item(p, lds, it);
            else if (it < 776) ret_chunk_item(p, lds, it - 256);
            else if (it < 1288) attn_sample_item(p, lds, it - 776);
            else ret_sample_item(p, lds, it - 1288);
        }
    }
    SEAM(2);
    if (PH(3)) REPS(3) { RSYNC; phase3_scan(p); }
    SEAM(3);
    if (PH(4)) REPS(4) { RSYNC; for (int it = bid; it < 512; it += nb) ret_out_item(p, lds, it); }
    SEAM(4);
    if (PH(5)) REPS(5) { RSYNC; pg8::Gemm g{(const bf16_t*)(ws + OFF_ACAT), (const bf16_t*)(ws + OFF_WCAT), MR2, DM, KCAT}; pg8::StaticOrder S; S.init(g.M, g.N, nb, bid);
        EpiMrg E{(const bf16_t*)(ws + OFF_U), (bf16_t*)(ws + OFF_MRG)}; pg8::gemm_phase<EpiMrg>(lds, g, S, E); }
    SEAM(5);
    if (PH(6)) REPS(6) { RSYNC; pg8::Gemm g{(const bf16_t*)(ws + OFF_MRG), (const bf16_t*)(ws + OFF_WO), MR2, DM, DM}; pg8::StaticOrder S; S.init(g.M, g.N, nb, bid);
        EpiOut E{p.x_prompt, p.x_sample, p.out + O_YP, p.out + O_YS}; pg8::gemm_phase<EpiOut>(lds, g, S, E); }
#undef REPS
#undef RSYNC
#undef PH
#undef SEAM
}

extern "C" void kernel_launch(void* const* d_in, const int* in_sizes, int n_in, void* d_out, int out_size, void* d_ws, size_t ws_size, hipStream_t stream) {
    static int grid = 0;
    if (grid == 0) {
        if (n_in != 16 || ws_size < WS_END) { fprintf(stderr, "kernel_launch: unexpected n_in %d / ws %zu (need %zu)\n", n_in, ws_size, (size_t)WS_END); grid = -1; return; }
        int dev = 0, cus = 0, per_cu = 0;
        hipGetDevice(&dev); hipDeviceGetAttribute(&cus, hipDeviceAttributeMultiprocessorCount, dev);
        if (hipFuncSetAttribute((const void*)mega, hipFuncAttributeMaxDynamicSharedMemorySize, LDS_BYTES) != hipSuccess) { fprintf(stderr, "kernel_launch: hipFuncSetAttribute failed\n"); grid = -1; return; }
        if (hipOccupancyMaxActiveBlocksPerMultiprocessor(&per_cu, (const void*)mega, 512, LDS_BYTES) != hipSuccess || per_cu < 1) { fprintf(stderr, "kernel_launch: occupancy query says %d\n", per_cu); per_cu = 1; (void)hipGetLastError(); }
        grid = cus;
    }
    if (grid < 0) return;
    Params p{};
    p.x_prompt = (const float*)d_in[0]; p.x_sample = (const float*)d_in[1]; p.cache_k = (const float*)d_in[2]; p.cache_v = (const float*)d_in[3]; p.state = (const float*)d_in[4];
    p.meta = (const float*)d_in[5]; p.norm_g = (const float*)d_in[6]; p.w_in = (const float*)d_in[7]; p.q_g = (const float*)d_in[8]; p.k_g = (const float*)d_in[9]; p.sinks = (const float*)d_in[10];
    p.gn_g = (const float*)d_in[11]; p.gn_b = (const float*)d_in[12]; p.w_pa = (const float*)d_in[13]; p.w_pr = (const float*)d_in[14]; p.w_o = (const float*)d_in[15];
    p.out = (float*)d_out; p.ws = (unsigned char*)d_ws; p.ph_lo = 0; p.ph_hi = 7;
    void* args[] = {&p};
    hipError_t e = hipLaunchCooperativeKernel((const void*)mega, dim3(grid), dim3(512), args, LDS_BYTES, stream);
    if (e != hipSuccess) fprintf(stderr, "cooperative launch failed: %s (grid %d)\n", hipGetErrorString(e), grid);
}
```

```cpp
#include <hip/hip_runtime.h>
#include <hip/hip_cooperative_groups.h>
#include <cstdio>
namespace cg = cooperative_groups;

#define LAS __attribute__((address_space(3)))
typedef unsigned short bf16_t;
typedef short bf16x8 __attribute__((ext_vector_type(8)));
typedef short bf16x4 __attribute__((ext_vector_type(4)));
typedef float f32x4 __attribute__((ext_vector_type(4)));
typedef float f32x2 __attribute__((ext_vector_type(2)));
typedef unsigned u32x4 __attribute__((ext_vector_type(4)));
typedef unsigned u32x2 __attribute__((ext_vector_type(2)));

constexpr int DM = 2048, NIN = 12800, MROWS = 8960, MR2 = 8704, TOKP = 8192, ROW_S = 8192, ROW_M = 8704;
constexpr int C_QA = 0, C_KA = 1024, C_VA = 1280, C_ZA = 1536, C_QR = 2560, C_KR = 3584, C_VR = 4608, C_ZR = 6656, C_GA = 8704, C_GR = 10752;
constexpr int UTP = 8960;
constexpr int UT_VA = 0, UT_KR = 256, UT_VR = 1280;
constexpr int TABP = 4128;
constexpr int KCAT = 3072;
constexpr size_t OFF_XN = 0, OFF_WINT = 36700160, OFF_ACAT = 0, OFF_MRG = 53477376;
constexpr size_t OFF_WCAT = 89128960, OFF_WO = OFF_WCAT + 12582912, OFF_U = OFF_WO + 8388608, OFF_UT = OFF_U + 229376000;
constexpr size_t OFF_UCT = OFF_UT + 59637760, OFF_SMT = OFF_UCT + 67108864, OFF_SPT = OFF_SMT + 1048576, OFF_TAB = OFF_SPT + 33554432;
constexpr size_t OFF_COSA = OFF_TAB, OFF_SINA = OFF_COSA + 132096, OFF_COSR = OFF_SINA + 132096, OFF_SINR = OFF_COSR + 1056768;
constexpr size_t OFF_COSRT = OFF_SINR + 1056768, OFF_SINRT = OFF_COSRT + 1056768, WS_END = OFF_SINRT + 1056768;
constexpr size_t O_YP = 0, O_YS = 16777216, O_WKP = 17825792, O_WVP = 17891328, O_RP = 17956864, O_WKS = 18481152, O_WVS = 22675456, O_RS = 26869760;
constexpr int LDS_BYTES = 160 * 1024;

struct Params {
    const float *x_prompt, *x_sample, *cache_k, *cache_v, *state, *meta, *norm_g, *w_in, *q_g, *k_g, *sinks, *gn_g, *gn_b, *w_pa, *w_pr, *w_o;
    float* out; unsigned char* ws; int ph_lo, ph_hi;
};

__device__ __forceinline__ unsigned cvt_pk_bf16(float lo, float hi) { unsigned r; asm("v_cvt_pk_bf16_f32 %0, %1, %2" : "=v"(r) : "v"(lo), "v"(hi)); return r; }
__device__ __forceinline__ bf16_t f2bf(float f) { return (bf16_t)(cvt_pk_bf16(f, 0.f) & 0xffffu); }
__device__ __forceinline__ float bf_lo(unsigned w) { return __uint_as_float(w << 16); }
__device__ __forceinline__ float bf_hi(unsigned w) { return __uint_as_float(w & 0xffff0000u); }
__device__ __forceinline__ float bf2f(bf16_t h) { return __uint_as_float(((unsigned)h) << 16); }
__device__ __forceinline__ float fast_exp(float x) { return __builtin_amdgcn_exp2f(x * 1.4426950408889634f); }
__device__ __forceinline__ float sigmoidf_(float x) { return __builtin_amdgcn_rcpf(1.0f + fast_exp(-x)); }
__device__ __forceinline__ float siluf_(float x) { return x * sigmoidf_(x); }
__device__ __forceinline__ float lg2_of(int h) {
    float r = -0.04580368961312479f;
    r = h == 1 ? -0.030662988889756927f : r; r = h == 2 ? -0.020562769581231145f : r; r = h == 3 ? -0.013805413024509017f : r;
    r = h == 4 ? -0.009275800472620728f : r; r = h == 5 ? -0.006235583073184706f : r; r = h == 6 ? -0.004193268921546044f : r;
    r = h == 7 ? -0.002820519062378663f : r; return r;
}
__device__ __forceinline__ void unpack8(u32x4 w, float* x) { x[0] = bf_lo(w.x); x[1] = bf_hi(w.x); x[2] = bf_lo(w.y); x[3] = bf_hi(w.y); x[4] = bf_lo(w.z); x[5] = bf_hi(w.z); x[6] = bf_lo(w.w); x[7] = bf_hi(w.w); }
__device__ __forceinline__ u32x4 pack8(const float* x) { u32x4 w; w.x = cvt_pk_bf16(x[0], x[1]); w.y = cvt_pk_bf16(x[2], x[3]); w.z = cvt_pk_bf16(x[4], x[5]); w.w = cvt_pk_bf16(x[6], x[7]); return w; }
__device__ __forceinline__ int pidx_of_row(int row) { return row < ROW_S ? 16 + (row & 4095) : (row < ROW_M ? 4112 + ((row - ROW_S) & 3) : row - ROW_M); }

namespace pg8 {
constexpr int BM = 256, BK = 64, HALF = 128, HTB = HALF * BK * 2, STAGE_BYTES = 8 * HTB, NXCD = 8, WGM = 8;
__device__ __forceinline__ int lds_byte(int r, int c) { const int st = (r >> 4) * 2 + (c >> 5), rr = r & 15, cc = c & 31, ob = rr * 64 + cc * 2; return st * 1024 + (ob ^ (((ob >> 9) & 1) << 5)); }
__device__ __forceinline__ void stage_rc(int b, int& R, int& C) { const int st = b / 1024, sb = b % 1024, swz = sb ^ (((sb >> 9) & 1) << 5); R = (st >> 1) * 16 + swz / 64; C = (st & 1) * 32 + (swz % 64) / 2; }
__device__ __forceinline__ int perm32(int rho) { const int n = rho >> 4, i = rho & 15; return 8 * (i >> 2) + 4 * n + (i & 3); }
struct Unit { int pm, pn; };
struct Gemm { const bf16_t* A; const bf16_t* Bt; int M, N, K; };
struct StaticOrder {
    int nM, nN, nwg, G, c;
    __device__ void init(int M, int N, int G_, int c_) { nM = M / BM; nN = N / BM; nwg = nM * nN; G = G_; c = c_; }
    __device__ bool next(int i, Unit& u) const {
        const long L = (long)i * G + c; if (L >= nwg) return false;
        int wgid = (int)L; { const int q = nwg / NXCD, r = nwg % NXCD, xcd = wgid % NXCD, off = wgid / NXCD; wgid = (xcd < r ? xcd * (q + 1) : r * (q + 1) + (xcd - r) * q) + off; }
        const int nig = WGM * nN, gid = wgid / nig, fm = gid * WGM, gsz = (nM - fm) < WGM ? (nM - fm) : WGM;
        u.pm = fm + ((wgid % nig) % gsz); u.pn = (wgid % nig) / gsz; return true;
    }
};

template <class Epi>
__device__ __forceinline__ void gemm_phase(LAS unsigned char* lds, const Gemm g, const StaticOrder& S, const Epi& E) {
    const int tid = threadIdx.x, wid = __builtin_amdgcn_readfirstlane(tid >> 6), lane = tid & 63, wr = wid >> 2, wc = wid & 3, fr = lane & 15, fq = lane >> 4;
    const int K = g.K, nt = K / BK;
    unsigned voffA[2], voffB[2];
#pragma unroll
    for (int i = 0; i < 2; ++i) { int R, C; stage_rc(tid * 16 + i * 8192, R, C); const int Rb = Epi::PERM ? ((R & ~31) + perm32(R & 31)) : R;
        voffA[i] = (unsigned)(R * K + C) * 2u; voffB[i] = (unsigned)(Rb * K + C) * 2u; }
    const size_t kstep = (size_t)(BK * 2);
    const size_t hstep = (size_t)HALF * K * 2;
    const size_t tstep = 2 * hstep;
    const unsigned ldsw = (unsigned)wid * 1024u;
    const int aoff = lds_byte(wr * 64 + fr, fq * 8), boff = lds_byte(wc * 32 + fr, fq * 8);
#define PG8_SA(b, h) (((b) * 2 + (h)) * HTB)
#define PG8_SB(b, h) ((4 + (b) * 2 + (h)) * HTB)
#define PG8_STAGE(bufoff, gbase, voff) do { _Pragma("unroll") for (int _i = 0; _i < 2; ++_i) \
        __builtin_amdgcn_global_load_lds((const unsigned*)((const char*)(gbase) + (voff)[_i]), (LAS unsigned*)(lds + (bufoff) + ldsw + _i * 8192), 16, 0, 0); } while (0)
#define PG8_LDA(dst, b, h) do { _Pragma("unroll") for (int m = 0; m < 4; ++m) _Pragma("unroll") for (int k = 0; k < 2; ++k) dst[m][k] = *(const LAS bf16x8*)(lds + PG8_SA(b, h) + aoff + m * 2048 + k * 1024); } while (0)
#define PG8_LDB(dst, b, h) do { _Pragma("unroll") for (int n = 0; n < 2; ++n) _Pragma("unroll") for (int k = 0; k < 2; ++k) dst[n][k] = *(const LAS bf16x8*)(lds + PG8_SB(b, h) + boff + n * 2048 + k * 1024); } while (0)
#define PG8_MMA(ai, bj, At, Bt) do { __builtin_amdgcn_s_setprio(1); _Pragma("unroll") for (int m = 0; m < 4; ++m) _Pragma("unroll") for (int n = 0; n < 2; ++n) _Pragma("unroll") for (int k = 0; k < 2; ++k) \
        acc[ai][bj][m][n] = __builtin_amdgcn_mfma_f32_16x16x32_bf16(Bt[n][k], At[m][k], acc[ai][bj][m][n], 0, 0, 0); __builtin_amdgcn_s_setprio(0); } while (0)
#define PG8_WAIT_V(n) asm volatile("s_waitcnt vmcnt(" #n ")" ::: "memory")
#define PG8_WAIT_L(n) asm volatile("s_waitcnt lgkmcnt(" #n ")" ::: "memory")
#define PG8_BAR __builtin_amdgcn_s_barrier()
#define PG8_SCHED __builtin_amdgcn_sched_barrier(0)
#define PG8_KBODY do { \
            const bool last = (t == nt - 2); \
            const char* a1 = cA + (size_t)(t + 1) * kstep; \
            const char* a2 = last ? nA : cA + (size_t)(t + 2) * kstep; const char* b2 = last ? nB : cB + (size_t)(t + 2) * kstep; \
            const char* a3 = a2 + kstep; const char* b3 = b2 + kstep; \
            PG8_LDB(B0, 0, 0); PG8_SCHED; PG8_LDA(At, 0, 0); PG8_STAGE(PG8_SA(1, 1), a1 + hstep, voffA); \
            PG8_WAIT_L(8); PG8_BAR; PG8_WAIT_L(0); PG8_MMA(0, 0, At, B0); PG8_BAR; PG8_SCHED; \
            PG8_LDB(B1, 0, 1); PG8_STAGE(PG8_SB(0, 0), b2, voffB); \
            PG8_BAR; PG8_WAIT_L(0); PG8_MMA(0, 1, At, B1); PG8_BAR; \
            PG8_LDA(At, 0, 1); PG8_STAGE(PG8_SA(0, 0), a2, voffA); \
            PG8_BAR; PG8_WAIT_L(0); PG8_MMA(1, 0, At, B0); PG8_BAR; PG8_SCHED; \
            PG8_STAGE(PG8_SB(0, 1), b2 + hstep, voffB); \
            PG8_WAIT_V(6); PG8_BAR; PG8_MMA(1, 1, At, B1); PG8_BAR; \
            PG8_LDB(B0, 1, 0); PG8_SCHED; PG8_LDA(At, 1, 0); PG8_STAGE(PG8_SA(0, 1), a2 + hstep, voffA); \
            PG8_WAIT_L(8); PG8_BAR; PG8_WAIT_L(0); PG8_MMA(0, 0, At, B0); PG8_BAR; PG8_SCHED; \
            PG8_LDB(B1, 1, 1); PG8_STAGE(PG8_SB(1, 0), b3, voffB); \
            PG8_BAR; PG8_WAIT_L(0); PG8_MMA(0, 1, At, B1); PG8_BAR; \
            PG8_LDA(At, 1, 1); PG8_STAGE(PG8_SA(1, 0), a3, voffA); \
            PG8_BAR; PG8_WAIT_L(0); PG8_MMA(1, 0, At, B0); PG8_BAR; PG8_SCHED; \
            PG8_STAGE(PG8_SB(1, 1), b3 + hstep, voffB); \
            PG8_WAIT_V(6); PG8_BAR; PG8_MMA(1, 1, At, B1); PG8_BAR; \
        } while (0)
    Unit cur, nxt; int ui = 0;
    if (!S.next(0, cur)) return;
    f32x4 acc[2][2][4][2];
#pragma unroll
    for (int a = 0; a < 2; ++a)
#pragma unroll
        for (int b = 0; b < 2; ++b)
#pragma unroll
            for (int m = 0; m < 4; ++m)
#pragma unroll
                for (int n = 0; n < 2; ++n) acc[a][b][m][n] = (f32x4){0.f, 0.f, 0.f, 0.f};
    bf16x8 At[4][2], B0[2][2], B1[2][2];
    const char* cA = (const char*)g.A + (size_t)cur.pm * tstep; const char* cB = (const char*)g.Bt + (size_t)cur.pn * tstep;
    PG8_STAGE(PG8_SB(0, 0), cB, voffB); PG8_STAGE(PG8_SA(0, 0), cA, voffA); PG8_STAGE(PG8_SB(0, 1), cB + hstep, voffB); PG8_STAGE(PG8_SA(0, 1), cA + hstep, voffA);
    if (wr == 1) PG8_BAR;
    PG8_WAIT_V(4); PG8_BAR;
    PG8_STAGE(PG8_SB(1, 0), cB + kstep, voffB); PG8_STAGE(PG8_SA(1, 0), cA + kstep, voffA); PG8_STAGE(PG8_SB(1, 1), cB + hstep + kstep, voffB);
    PG8_WAIT_V(6); PG8_BAR;
    for (;;) {
        const bool has_next = S.next(ui + 1, nxt);
        const char* nA = has_next ? (const char*)g.A + (size_t)nxt.pm * tstep : cA; const char* nB = has_next ? (const char*)g.Bt + (size_t)nxt.pn * tstep : cB;
        if constexpr (Epi::MID_T > 0) {
            for (int t = 0; t < Epi::MID_T; t += 2) PG8_KBODY;
            E.mid(acc, cur, wr, wc, fr, fq);
            for (int t = Epi::MID_T; t < nt; t += 2) PG8_KBODY;
        } else {
            for (int t = 0; t < nt; t += 2) PG8_KBODY;
        }
        E(acc, cur, wr, wc, fr, fq);
        if (!has_next) break;
#pragma unroll
        for (int a = 0; a < 2; ++a)
#pragma unroll
            for (int b = 0; b < 2; ++b)
#pragma unroll
                for (int m = 0; m < 4; ++m)
#pragma unroll
                    for (int n = 0; n < 2; ++n) acc[a][b][m][n] = (f32x4){0.f, 0.f, 0.f, 0.f};
        cur = nxt; cA = nA; cB = nB; ++ui;
    }
    PG8_WAIT_V(0);
    if (wr == 0) PG8_BAR;
    PG8_BAR;
#undef PG8_KBODY
#undef PG8_SA
#undef PG8_SB
#undef PG8_STAGE
#undef PG8_LDA
#undef PG8_LDB
#undef PG8_MMA
#undef PG8_WAIT_V
#undef PG8_WAIT_L
#undef PG8_BAR
#undef PG8_SCHED
}
}

struct EpiU {
    static constexpr bool PERM = true; static constexpr int MID_T = 0;
    bf16_t* U; bf16_t* UT;
    __device__ __forceinline__ void operator()(const f32x4 (&acc)[2][2][4][2], const pg8::Unit& u, int wr, int wc, int fr, int fq) const {
        const int row0 = u.pm * 256 + wr * 64 + fr, col0 = u.pn * 256 + wc * 32 + 8 * fq;
#pragma unroll
        for (int ai = 0; ai < 2; ++ai)
#pragma unroll
            for (int m = 0; m < 4; ++m) { bf16_t* rowp = U + (size_t)(row0 + ai * 128 + m * 16) * NIN + col0;
#pragma unroll
                for (int bj = 0; bj < 2; ++bj) { const f32x4 v0 = acc[ai][bj][m][0], v1 = acc[ai][bj][m][1];
                    u32x4 w; w.x = cvt_pk_bf16(v0[0], v0[1]); w.y = cvt_pk_bf16(v0[2], v0[3]); w.z = cvt_pk_bf16(v1[0], v1[1]); w.w = cvt_pk_bf16(v1[2], v1[3]);
                    *(u32x4*)(rowp + bj * 128) = w; } }
        int trow = -1;
        if (u.pn == 5) trow = UT_VA; else if (u.pn >= 14 && u.pn < 18) trow = UT_KR + (u.pn - 14) * 256; else if (u.pn >= 18 && u.pn < 26) trow = UT_VR + (u.pn - 18) * 256;
        if (trow >= 0) {
            bf16_t* base = UT + (size_t)(trow + wc * 32 + 8 * fq) * UTP + row0;
#pragma unroll
            for (int bj = 0; bj < 2; ++bj)
#pragma unroll
                for (int n = 0; n < 2; ++n)
#pragma unroll
                    for (int j = 0; j < 4; ++j) { bf16_t* cp = base + (size_t)(bj * 128 + 4 * n + j) * UTP;
#pragma unroll
                        for (int ai = 0; ai < 2; ++ai)
#pragma unroll
                            for (int m = 0; m < 4; ++m) cp[ai * 128 + m * 16] = f2bf(acc[ai][bj][m][n][j]); }
        }
    }
};
struct EpiMrg {
    static constexpr bool PERM = true; static constexpr int MID_T = 16;
    const bf16_t* U; bf16_t* O;
    __device__ __forceinline__ void mid(f32x4 (&acc)[2][2][4][2], const pg8::Unit& u, int wr, int wc, int fr, int fq) const {
        int row0 = u.pm * 256 + wr * 64 + fr; const int col0 = u.pn * 256 + wc * 32 + 8 * fq;
        asm volatile("" : "+v"(row0));
        const unsigned off0 = ((unsigned)row0 * NIN + col0) * 2u;
        const char* Ub = (const char*)U;
        u32x4 wa[3], wg[3];
#define GOFF(g) (off0 + (unsigned)(((((g) >> 3) * 128 + (((g) >> 1) & 3) * 16) * NIN + ((g) & 1) * 128) * 2))
#pragma unroll
        for (int g = 0; g < 2; ++g) { wa[g] = *(const u32x4*)(Ub + GOFF(g) + C_GA * 2); wg[g] = *(const u32x4*)(Ub + GOFF(g) + C_GR * 2); }
#pragma unroll
        for (int g = 0; g < 16; ++g) {
            if (g + 2 < 16) { wa[(g + 2) % 3] = *(const u32x4*)(Ub + GOFF(g + 2) + C_GA * 2); wg[(g + 2) % 3] = *(const u32x4*)(Ub + GOFF(g + 2) + C_GR * 2); }
            float a[8], r[8]; unpack8(wa[g % 3], a); unpack8(wg[g % 3], r);
#pragma unroll
            for (int e = 0; e < 8; ++e) { const float ratio = (1.0f + fast_exp(-r[e])) * __builtin_amdgcn_rcpf(1.0f + fast_exp(-a[e])); acc[g >> 3][g & 1][(g >> 1) & 3][e >> 2][e & 3] *= ratio; }
            __builtin_amdgcn_sched_barrier(0);
        }
    }
    __device__ __forceinline__ void operator()(const f32x4 (&acc)[2][2][4][2], const pg8::Unit& u, int wr, int wc, int fr, int fq) const {
        int row0 = u.pm * 256 + wr * 64 + fr; const int col0 = u.pn * 256 + wc * 32 + 8 * fq;
        asm volatile("" : "+v"(row0));
        const unsigned off0 = ((unsigned)row0 * NIN + col0) * 2u, ooff0 = ((unsigned)row0 * DM + col0) * 2u;
        const char* Ub = (const char*)U; char* Ob = (char*)O;
        u32x4 wg[16];
#pragma unroll
        for (int g = 0; g < 16; ++g) wg[g] = *(const u32x4*)(Ub + GOFF(g) + C_GR * 2);
#pragma unroll
        for (int g = 0; g < 16; ++g) {
            float r[8], o[8]; unpack8(wg[g], r);
#pragma unroll
            for (int e = 0; e < 8; ++e) o[e] = acc[g >> 3][g & 1][(g >> 1) & 3][e >> 2][e & 3] * sigmoidf_(r[e]);
            *(u32x4*)(Ob + ooff0 + (unsigned)((((g >> 3) * 128 + ((g >> 1) & 3) * 16) * DM + (g & 1) * 128) * 2)) = pack8(o);
        }
#undef GOFF
    }
};
struct EpiOut {
    static constexpr bool PERM = false; static constexpr int MID_T = 0;
    const float* xp; const float* xs; float* yp; float* ys;
    __device__ __forceinline__ void operator()(const f32x4 (&acc)[2][2][4][2], const pg8::Unit& u, int wr, int wc, int fr, int fq) const {
        int row0 = u.pm * 256 + wr * 64 + fr; const int col0 = u.pn * 256 + wc * 32 + 4 * fq;
        asm volatile("" : "+v"(row0));
        const float* xb = u.pm < 32 ? xp : xs - (size_t)TOKP * DM; float* yb = u.pm < 32 ? yp : ys - (size_t)TOKP * DM;
        const unsigned off0 = ((unsigned)row0 * DM + col0) * 4u;
        const char* Xb = (const char*)xb; char* Yb = (char*)yb;
        f32x4 xv[2][4];
#define GOFF(q, k) (off0 + (unsigned)(((((q) >> 2) * 128 + ((q) & 3) * 16) * DM + ((k) >> 1) * 128 + ((k) & 1) * 16) * 4))
#pragma unroll
        for (int k = 0; k < 4; ++k) xv[0][k] = *(const f32x4*)(Xb + GOFF(0, k));
#pragma unroll
        for (int q = 0; q < 8; ++q) {
            if (q + 1 < 8) {
#pragma unroll
                for (int k = 0; k < 4; ++k) xv[(q + 1) & 1][k] = *(const f32x4*)(Xb + GOFF(q + 1, k)); }
#pragma unroll
            for (int k = 0; k < 4; ++k) *(f32x4*)(Yb + GOFF(q, k)) = xv[q & 1][k] + acc[q >> 2][k >> 1][q & 3][k & 1];
            __builtin_amdgcn_sched_barrier(0);
        }
#undef GOFF
    }
};

__device__ __forceinline__ void wtile(const float* W, int N, bf16_t* Wt, int ldt, int koff, int k0, int n0, LAS float* sT, int tid) {
    const int r = tid >> 3, cg = (tid & 7) * 4;
    const float* src = W + (size_t)(k0 + r) * N + n0 + cg;
    f32x4 v[8];
#pragma unroll
    for (int q = 0; q < 8; ++q) v[q] = __builtin_nontemporal_load((const f32x4*)(src + q * 32));
#pragma unroll
    for (int q = 0; q < 8; ++q) { LAS float* d = sT + r * 257 + cg + q * 32; d[0] = v[q][0]; d[1] = v[q][1]; d[2] = v[q][2]; d[3] = v[q][3]; }
    __syncthreads();
    const int nn = tid >> 2, k8 = (tid & 3) * 8;
#pragma unroll
    for (int q = 0; q < 4; ++q) { const int n = nn + q * 128; float o[8];
#pragma unroll
        for (int i = 0; i < 8; ++i) o[i] = sT[(k8 + (q & 1) * 32 + i) * 257 + nn + (q >> 1) * 128];
        (void)n;
        *(u32x4*)(Wt + (size_t)(n0 + nn + (q >> 1) * 128) * ldt + koff + k0 + k8 + (q & 1) * 32) = pack8(o); }
    __syncthreads();
}
__device__ void phase0(const Params& p, LAS unsigned char* lds) {
    const int tid = threadIdx.x, lane = tid & 63, wid = tid >> 6, bid = blockIdx.x, nb = gridDim.x;
    unsigned char* ws = p.ws;
    { float* cosA = (float*)(ws + OFF_COSA); float* sinA = (float*)(ws + OFF_SINA);
      for (int e = bid * 512 + tid; e < 4116 * 8; e += nb * 512) { const int pidx = e >> 3, i = e & 7; const double pos = pidx < 4112 ? (double)pidx : (double)(16384 + pidx - 4112);
          const double inv = exp(-13.122363377404328 * (2.0 * i / 16.0)); double rev = pos * inv * 0.15915494309189535; rev -= rint(rev);
          cosA[e] = __builtin_amdgcn_cosf((float)rev); sinA[e] = __builtin_amdgcn_sinf((float)rev); }
      float* cosR = (float*)(ws + OFF_COSR); float* sinR = (float*)(ws + OFF_SINR); float* cosRT = (float*)(ws + OFF_COSRT); float* sinRT = (float*)(ws + OFF_SINRT);
      for (int e = bid * 512 + tid; e < 4116 * 64; e += nb * 512) { const int pidx = e >> 6, i = e & 63; const double pos = pidx < 4112 ? (double)pidx : (double)(16384 + pidx - 4112);
          const double inv = exp(-9.210340371976182 * (2.0 * i / 128.0)); double rev = pos * inv * 0.15915494309189535; rev -= rint(rev);
          const float c = __builtin_amdgcn_cosf((float)rev), s = __builtin_amdgcn_sinf((float)rev);
          cosR[e] = c; sinR[e] = s; cosRT[i * TABP + pidx] = c; sinRT[i * TABP + pidx] = s; } }
    { bf16_t* Xn = (bf16_t*)(ws + OFF_XN);
      for (int row = bid * 8 + wid; row < MROWS; row += nb * 8) {
          bf16_t* dst = Xn + (size_t)row * DM;
          const float* src = row < ROW_S ? p.x_prompt + (size_t)row * DM : (row < ROW_M ? p.x_sample + (size_t)(row - ROW_S) * DM : (row < ROW_M + 16 ? p.meta + (size_t)(row - ROW_M) * DM : nullptr));
          if (!src) {
#pragma unroll
              for (int i = 0; i < 4; ++i) *(u32x4*)(dst + (i * 64 + lane) * 8) = (u32x4){0u, 0u, 0u, 0u};
              continue; }
          f32x4 v[8]; float ss = 0.f;
#pragma unroll
          for (int i = 0; i < 8; ++i) { v[i] = *(const f32x4*)(src + (i * 64 + lane) * 4); ss += v[i][0] * v[i][0] + v[i][1] * v[i][1] + v[i][2] * v[i][2] + v[i][3] * v[i][3]; }
#pragma unroll
          for (int o = 1; o < 64; o <<= 1) ss += __shfl_xor(ss, o);
          const float rs = rsqrtf(ss * (1.0f / 2048.0f) + 1e-6f);
#pragma unroll
          for (int i = 0; i < 8; ++i) { const f32x4 g = *(const f32x4*)(p.norm_g + (i * 64 + lane) * 4);
              u32x2 w; w.x = cvt_pk_bf16(v[i][0] * rs * g[0], v[i][1] * rs * g[1]); w.y = cvt_pk_bf16(v[i][2] * rs * g[2], v[i][3] * rs * g[3]);
              *(u32x2*)(dst + (i * 64 + lane) * 4) = w; }
      } }
    { LAS float* sT = (LAS float*)lds;
      bf16_t* WinT = (bf16_t*)(ws + OFF_WINT); bf16_t* WcatT = (bf16_t*)(ws + OFF_WCAT); bf16_t* WoT = (bf16_t*)(ws + OFF_WO);
      for (int t = bid; t < 2240; t += nb) {
          if (t < 1600) { const int kt = t / 50, ntile = t % 50; wtile(p.w_in, NIN, WinT, DM, 0, kt * 64, ntile * 256, sT, tid); }
          else if (t < 1728) { const int q = t - 1600, kt = q >> 3, ntile = q & 7; wtile(p.w_pa, DM, WcatT, KCAT, 0, kt * 64, ntile * 256, sT, tid); }
          else if (t < 1984) { const int q = t - 1728, kt = q >> 3, ntile = q & 7; wtile(p.w_pr, DM, WcatT, KCAT, 1024, kt * 64, ntile * 256, sT, tid); }
          else { const int q = t - 1984, kt = q >> 3, ntile = q & 7; wtile(p.w_o, DM, WoT, DM, 0, kt * 64, ntile * 256, sT, tid); }
      } }
}

__device__ __forceinline__ void headnorm_rope(float (&x)[64], const LAS float* gain, const float* __restrict__ cs, const float* __restrict__ sn, float scale) {
    float ss = 0.f;
#pragma unroll
    for (int d = 0; d < 64; ++d) ss += x[d] * x[d];
    const float rs = rsqrtf(ss * (1.0f / 64.0f) + 1e-6f);
#pragma unroll
    for (int d4 = 0; d4 < 16; ++d4) { const f32x4 g = *(const LAS f32x4*)(gain + d4 * 4); x[d4 * 4] *= rs * g[0]; x[d4 * 4 + 1] *= rs * g[1]; x[d4 * 4 + 2] *= rs * g[2]; x[d4 * 4 + 3] *= rs * g[3]; }
#pragma unroll
    for (int i = 0; i < 8; ++i) { const float c = cs[i], s = sn[i], x1 = x[i], x2 = x[i + 8]; x[i] = x1 * c - x2 * s; x[i + 8] = x2 * c + x1 * s; }
#pragma unroll
    for (int d = 0; d < 64; ++d) x[d] *= scale;
}
__device__ __forceinline__ void load_row64_bf16(const bf16_t* src, float (&x)[64]) {
#pragma unroll
    for (int c = 0; c < 8; ++c) { const u32x4 w = *(const u32x4*)(src + c * 8); unpack8(w, &x[c * 8]); }
}
__device__ __forceinline__ void load_row64_f32(const float* src, float (&x)[64]) {
#pragma unroll
    for (int c = 0; c < 16; ++c) { const f32x4 w = *(const f32x4*)(src + c * 4); x[c * 4] = w[0]; x[c * 4 + 1] = w[1]; x[c * 4 + 2] = w[2]; x[c * 4 + 3] = w[3]; }
}
__device__ __forceinline__ void store_row64_lds(LAS bf16_t* dst, const float (&x)[64]) {
#pragma unroll
    for (int c = 0; c < 8; ++c) *(LAS u32x4*)(dst + c * 8) = pack8(&x[c * 8]);
}
__device__ __forceinline__ void store_row64_f32(float* dst, const float (&x)[64]) {
#pragma unroll
    for (int c = 0; c < 16; ++c) *(f32x4*)(dst + c * 4) = (f32x4){x[c * 4], x[c * 4 + 1], x[c * 4 + 2], x[c * 4 + 3]};
}
template <int NKT, class MaskF>
__device__ __forceinline__ void attn_tile16(const LAS bf16_t* sQ, int qp, const LAS bf16_t* sK, int kp, const LAS bf16_t* sVt, int vp, float sinkv, MaskF mask, f32x4 (&o)[4], int lane) {
    const int fr = lane & 15, fq = lane >> 4;
    bf16x8 qf[2];
#pragma unroll
    for (int ks = 0; ks < 2; ++ks) qf[ks] = *(const LAS bf16x8*)(sQ + fr * qp + ks * 32 + fq * 8);
    f32x4 s[NKT];
#pragma unroll
    for (int kt = 0; kt < NKT; ++kt) { s[kt] = (f32x4){0.f, 0.f, 0.f, 0.f};
#pragma unroll
        for (int ks = 0; ks < 2; ++ks) { const bf16x8 kf = *(const LAS bf16x8*)(sK + (kt * 16 + fr) * kp + ks * 32 + fq * 8); s[kt] = __builtin_amdgcn_mfma_f32_16x16x32_bf16(kf, qf[ks], s[kt], 0, 0, 0); } }
    float mx = sinkv;
#pragma unroll
    for (int kt = 0; kt < NKT; ++kt)
#pragma unroll
        for (int r = 0; r < 4; ++r) { const float v = mask(kt * 16 + fq * 4 + r) ? s[kt][r] : -1e30f; s[kt][r] = v; mx = fmaxf(mx, v); }
    mx = fmaxf(mx, __shfl_xor(mx, 16)); mx = fmaxf(mx, __shfl_xor(mx, 32));
    float sum = 0.f;
#pragma unroll
    for (int kt = 0; kt < NKT; ++kt)
#pragma unroll
        for (int r = 0; r < 4; ++r) { const float pe = fast_exp(s[kt][r] - mx); s[kt][r] = pe; sum += pe; }
    sum += __shfl_xor(sum, 16); sum += __shfl_xor(sum, 32);
    sum += fast_exp(sinkv - mx);
    const float inv = 1.0f / sum;
#pragma unroll
    for (int dt = 0; dt < 4; ++dt) o[dt] = (f32x4){0.f, 0.f, 0.f, 0.f};
#pragma unroll
    for (int k2 = 0; k2 < NKT / 2; ++k2) {
        u32x4 pw; pw.x = cvt_pk_bf16(s[2 * k2][0], s[2 * k2][1]); pw.y = cvt_pk_bf16(s[2 * k2][2], s[2 * k2][3]); pw.z = cvt_pk_bf16(s[2 * k2 + 1][0], s[2 * k2 + 1][1]); pw.w = cvt_pk_bf16(s[2 * k2 + 1][2], s[2 * k2 + 1][3]);
        const bf16x8 pf = __builtin_bit_cast(bf16x8, pw);
#pragma unroll
        for (int dt = 0; dt < 4; ++dt) { const LAS bf16_t* vr = sVt + (dt * 16 + fr) * vp + k2 * 32 + fq * 4;
            const u32x2 lo = *(const LAS u32x2*)vr, hi = *(const LAS u32x2*)(vr + 16);
            const u32x4 vw = (u32x4){lo.x, lo.y, hi.x, hi.y};
            o[dt] = __builtin_amdgcn_mfma_f32_16x16x32_bf16(__builtin_bit_cast(bf16x8, vw), pf, o[dt], 0, 0, 0); }
    }
#pragma unroll
    for (int dt = 0; dt < 4; ++dt) o[dt] *= inv;
}

__device__ void attn_prompt_item(const Params& p, LAS unsigned char* lds, int item) {
    int tid_ = threadIdx.x; asm volatile("" : "+v"(tid_)); const int tid = tid_, lane = tid & 63, wid = __builtin_amdgcn_readfirstlane(tid >> 6);
    const int kvh = item & 3, blk = (item >> 2) & 31, b = item >> 7;
    const bf16_t* U = (const bf16_t*)(p.ws + OFF_U); const bf16_t* UT = (const bf16_t*)(p.ws + OFF_UT); bf16_t* Acat = (bf16_t*)(p.ws + OFF_ACAT);
    const float* cosA = (const float*)(p.ws + OFF_COSA); const float* sinA = (const float*)(p.ws + OFF_SINA);
    constexpr int QP = 72, KP = 72, VP = 296;
    LAS bf16_t* sQ = (LAS bf16_t*)lds; LAS bf16_t* sK = sQ + 512 * QP; LAS bf16_t* sVt = sK + 288 * KP; LAS float* sG = (LAS float*)(sVt + 64 * VP);
    const int tok0 = blk * 128;
    if (tid < 128) sG[tid] = tid < 64 ? p.q_g[tid] : p.k_g[tid - 64];
    __syncthreads();
    {
        const int g = tid >> 7, tok = tid & 127; const int row = b * 4096 + tok0 + tok; const int pidx = 16 + tok0 + tok;
        float x[64]; load_row64_bf16(U + (size_t)row * NIN + C_QA + (kvh * 4 + g) * 64, x);
        headnorm_rope(x, sG, cosA + pidx * 8, sinA + pidx * 8, 0.125f);
        store_row64_lds(sQ + tid * QP, x);
    }
    __builtin_amdgcn_sched_barrier(0);
    if (tid < 288) {
        float x[64];
        int row = -1, pidx = 0;
        if (tid < 16) { row = ROW_M + tid; pidx = tid; }
        else if (tid < 272) { const int tk = tok0 - 128 + (tid - 16); if (tk >= 0) { row = b * 4096 + tk; pidx = 16 + tk; } }
        if (row >= 0) { load_row64_bf16(U + (size_t)row * NIN + C_KA + kvh * 64, x); headnorm_rope(x, sG + 64, cosA + pidx * 8, sinA + pidx * 8, 1.0f); }
        else {
#pragma unroll
            for (int d = 0; d < 64; ++d) x[d] = 0.f; }
        store_row64_lds(sK + tid * KP, x);
        if (blk == 31 && tid >= 144 && tid < 272) store_row64_f32(p.out + O_WKP + ((size_t)(b * 128 + (tid - 144)) * 4 + kvh) * 64, x);
    }
    { u32x4 tmp[5];
#pragma unroll
      for (int q = 0; q < 5; ++q) { const int c = tid + q * 512; tmp[q] = (u32x4){0u, 0u, 0u, 0u};
        if (c < 64 * 37) { const int d = c / 37, ch = c % 37; const bf16_t* src = UT + (size_t)(UT_VA + kvh * 64 + d) * UTP;
          if (ch < 2) tmp[q] = *(const u32x4*)(src + ROW_M + ch * 8);
          else if (ch < 34) { const int tk = tok0 - 128 + (ch - 2) * 8; if (tk >= 0) tmp[q] = *(const u32x4*)(src + b * 4096 + tk); } } }
#pragma unroll
      for (int q = 0; q < 5; ++q) { const int c = tid + q * 512; if (c < 64 * 37) { const int d = c / 37, ch = c % 37; *(LAS u32x4*)(sVt + d * VP + ch * 8) = tmp[q]; } } }
    if (blk == 31) { u32x4 tmp[2];
#pragma unroll
      for (int q = 0; q < 2; ++q) { const int e = tid + q * 512; const int tk = e >> 3, d8 = (e & 7) * 8; tmp[q] = *(const u32x4*)(U + (size_t)(b * 4096 + 3968 + tk) * NIN + C_VA + kvh * 64 + d8); }
#pragma unroll
      for (int q = 0; q < 2; ++q) { const int e = tid + q * 512; const int tk = e >> 3, d8 = (e & 7) * 8; float x[8]; unpack8(tmp[q], x);
        float* o = p.out + O_WVP + ((size_t)(b * 128 + tk) * 4 + kvh) * 64 + d8; *(f32x4*)o = (f32x4){x[0], x[1], x[2], x[3]}; *(f32x4*)(o + 4) = (f32x4){x[4], x[5], x[6], x[7]}; } }
    __syncthreads();
    const int g = wid >> 1, half = wid & 1, fr = lane & 15, fq = lane >> 4;
    const float sinkv = p.sinks[kvh * 4 + g];
#pragma unroll 1
    for (int mt_ = 0; mt_ < 4; ++mt_) {
        int mt = mt_; asm volatile("" : "+s"(mt));
        const int qi = half * 64 + mt * 16 + fr;
        f32x4 o[4];
        auto mask = [&](int kidx) -> bool { const int kj = kidx - 144; return kidx < 16 || (kidx < 272 && kj <= qi && kj > qi - 128 && tok0 + kj >= 0); };
        const size_t row = (size_t)(b * 4096 + tok0 + qi); const int hc = (kvh * 4 + g) * 64;
        u32x2 zq[4];
#pragma unroll
        for (int dt = 0; dt < 4; ++dt) zq[dt] = *(const u32x2*)(U + row * NIN + C_ZA + hc + dt * 16 + fq * 4);
        attn_tile16<18>(sQ + (g * 128 + half * 64 + mt * 16) * QP, QP, sK, KP, sVt, VP, sinkv, mask, o, lane);
#pragma unroll
        for (int dt = 0; dt < 4; ++dt) { const int d = dt * 16 + fq * 4;
            const u32x2 zw = zq[dt];
            u32x2 w; w.x = cvt_pk_bf16(o[dt][0] * siluf_(bf_lo(zw.x)), o[dt][1] * siluf_(bf_hi(zw.x))); w.y = cvt_pk_bf16(o[dt][2] * siluf_(bf_lo(zw.y)), o[dt][3] * siluf_(bf_hi(zw.y)));
            *(u32x2*)(Acat + row * KCAT + hc + d) = w; }
    }
    __syncthreads();
}

__device__ void attn_sample_item(const Params& p, LAS unsigned char* lds, int item) {
    int tid_ = threadIdx.x; asm volatile("" : "+v"(tid_)); const int tid = tid_, lane = tid & 63, wid = __builtin_amdgcn_readfirstlane(tid >> 6);
    const int kvh = item & 3, bs = item >> 2;
    const bf16_t* U = (const bf16_t*)(p.ws + OFF_U); const bf16_t* UT = (const bf16_t*)(p.ws + OFF_UT); bf16_t* Acat = (bf16_t*)(p.ws + OFF_ACAT);
    const float* cosA = (const float*)(p.ws + OFF_COSA); const float* sinA = (const float*)(p.ws + OFF_SINA);
    constexpr int QP = 72, KP = 72, VP = 168;
    LAS bf16_t* sQ = (LAS bf16_t*)lds; LAS bf16_t* sK = sQ + 16 * QP; LAS bf16_t* sVt = sK + 160 * KP; LAS float* sG = (LAS float*)(sVt + 64 * VP);
    if (tid < 128) sG[tid] = tid < 64 ? p.q_g[tid] : p.k_g[tid - 64];
    __syncthreads();
    if (tid < 160) {
        float x[64];
        if (tid < 16) { load_row64_bf16(U + (size_t)(ROW_M + tid) * NIN + C_KA + kvh * 64, x); headnorm_rope(x, sG + 64, cosA + tid * 8, sinA + tid * 8, 1.0f); }
        else if (tid < 144) { const int c = tid - 16; load_row64_f32(p.cache_k + ((size_t)(bs * 128 + c) * 4 + kvh) * 64, x);
            if (c >= 4) store_row64_f32(p.out + O_WKS + ((size_t)(bs * 128 + c - 4) * 4 + kvh) * 64, x); }
        else if (tid < 148) { const int i = tid - 144; load_row64_bf16(U + (size_t)(ROW_S + bs * 4 + i) * NIN + C_KA + kvh * 64, x);
            headnorm_rope(x, sG + 64, cosA + (4112 + i) * 8, sinA + (4112 + i) * 8, 1.0f);
            store_row64_f32(p.out + O_WKS + ((size_t)(bs * 128 + 124 + i) * 4 + kvh) * 64, x); }
        else {
#pragma unroll
            for (int d = 0; d < 64; ++d) x[d] = 0.f; }
        store_row64_lds(sK + tid * KP, x);
    } else if (tid >= 192 && tid < 208) {
        const int r = tid - 192, g = r >> 2, i = r & 3;
        float x[64]; load_row64_bf16(U + (size_t)(ROW_S + bs * 4 + i) * NIN + C_QA + (kvh * 4 + g) * 64, x);
        headnorm_rope(x, sG, cosA + (4112 + i) * 8, sinA + (4112 + i) * 8, 0.125f);
        store_row64_lds(sQ + r * QP, x);
    }
    { float xv[3][8];
#pragma unroll
      for (int q = 0; q < 3; ++q) { const int t = tid + q * 512; const int key = t >> 3, d8 = (t & 7) * 8;
#pragma unroll
        for (int e = 0; e < 8; ++e) xv[q][e] = 0.f;
        if (t < 168 * 8) {
          if (key < 16) { const u32x4 w = *(const u32x4*)(U + (size_t)(ROW_M + key) * NIN + C_VA + kvh * 64 + d8); unpack8(w, xv[q]); }
          else if (key < 144) { const float* s = p.cache_v + ((size_t)(bs * 128 + key - 16) * 4 + kvh) * 64 + d8; const f32x4 a = *(const f32x4*)s, c = *(const f32x4*)(s + 4);
              xv[q][0] = a[0]; xv[q][1] = a[1]; xv[q][2] = a[2]; xv[q][3] = a[3]; xv[q][4] = c[0]; xv[q][5] = c[1]; xv[q][6] = c[2]; xv[q][7] = c[3]; }
          else if (key < 148) { const u32x4 w = *(const u32x4*)(U + (size_t)(ROW_S + bs * 4 + key - 144) * NIN + C_VA + kvh * 64 + d8); unpack8(w, xv[q]); } } }
#pragma unroll
      for (int q = 0; q < 3; ++q) { const int t = tid + q * 512; const int key = t >> 3, d8 = (t & 7) * 8;
        if (t < 168 * 8) {
#pragma unroll
          for (int e = 0; e < 8; ++e) sVt[(d8 + e) * VP + key] = f2bf(xv[q][e]);
          if (key >= 20 && key < 148) { float* o = p.out + O_WVS + ((size_t)(bs * 128 + key - 20) * 4 + kvh) * 64 + d8;
              *(f32x4*)o = (f32x4){xv[q][0], xv[q][1], xv[q][2], xv[q][3]}; *(f32x4*)(o + 4) = (f32x4){xv[q][4], xv[q][5], xv[q][6], xv[q][7]}; } } } }
    __syncthreads();
    if (wid == 0) {
        const int fr = lane & 15, fq = lane >> 4, g = fr >> 2, i = fr & 3;
        const float sinkv = p.sinks[kvh * 4 + g];
        f32x4 o[4];
        auto mask = [&](int kidx) -> bool { return kidx < 16 || (kidx < 144 ? (kidx - 16) > i : (kidx < 148 && (kidx - 144) <= i)); };
        attn_tile16<10>(sQ, QP, sK, KP, sVt, VP, sinkv, mask, o, lane);
        const size_t row = (size_t)(ROW_S + bs * 4 + i); const int hc = (kvh * 4 + g) * 64;
        u32x2 zq[4];
#pragma unroll
        for (int dt = 0; dt < 4; ++dt) zq[dt] = *(const u32x2*)(U + row * NIN + C_ZA + hc + dt * 16 + fq * 4);
#pragma unroll
        for (int dt = 0; dt < 4; ++dt) { const int d = dt * 16 + fq * 4;
            const u32x2 zw = zq[dt];
            u32x2 w; w.x = cvt_pk_bf16(o[dt][0] * siluf_(bf_lo(zw.x)), o[dt][1] * siluf_(bf_hi(zw.x))); w.y = cvt_pk_bf16(o[dt][2] * siluf_(bf_lo(zw.y)), o[dt][3] * siluf_(bf_hi(zw.y)));
            *(u32x2*)(Acat + row * KCAT + hc + d) = w; }
    }
    __syncthreads();
}

__device__ void ret_chunk_item(const Params& p, LAS unsigned char* lds, int item) {
    int tid_ = threadIdx.x; asm volatile("" : "+v"(tid_)); const int tid = tid_, lane = tid & 63, wid = __builtin_amdgcn_readfirstlane(tid >> 6), fr = lane & 15, fq = lane >> 4;
    const bf16_t* UT = (const bf16_t*)(p.ws + OFF_UT);
    const float* cosRT = (const float*)(p.ws + OFF_COSRT); const float* sinRT = (const float*)(p.ws + OFF_SINRT);
    int h, tokrow0, pidx0, C, nks; float* dst;
    if (item < 512) { h = item & 7; const int c = (item >> 3) & 31, b = item >> 8; tokrow0 = b * 4096 + c * 128; pidx0 = 16 + c * 128; C = 128; nks = 4; dst = (float*)(p.ws + OFF_UCT) + (size_t)item * 32768; }
    else { h = item - 512; tokrow0 = ROW_M; pidx0 = 0; C = 16; nks = 1; dst = (float*)(p.ws + OFF_SMT) + (size_t)h * 32768; }
    const int ntok = nks * 32;
    constexpr int TP = 136;
    LAS bf16_t* sKt = (LAS bf16_t*)lds; LAS bf16_t* sVt = sKt + 128 * TP;
    const float lg2 = lg2_of(h);
    const int nshift = nks == 4 ? 4 : 2, nch = 1 << nshift;
#pragma unroll
    for (int q = 0; q < 2; ++q) { const int t = tid + q * 512; if (t < (64 << nshift)) { const int i = t >> nshift, ch = t & (nch - 1);
        const bf16_t* s1 = UT + (size_t)(UT_KR + h * 128 + i) * UTP + tokrow0 + ch * 8;
        const u32x4 wa = *(const u32x4*)s1, wb = *(const u32x4*)(s1 + (size_t)64 * UTP);
        float a[8], bb[8], cs[8], sn[8], o1[8], o2[8]; unpack8(wa, a); unpack8(wb, bb);
        const float* cp = cosRT + i * TABP + pidx0 + ch * 8; const float* sp = sinRT + i * TABP + pidx0 + ch * 8;
        const f32x4 c0 = *(const f32x4*)cp, c1 = *(const f32x4*)(cp + 4), s0 = *(const f32x4*)sp, s1v = *(const f32x4*)(sp + 4);
        cs[0] = c0[0]; cs[1] = c0[1]; cs[2] = c0[2]; cs[3] = c0[3]; cs[4] = c1[0]; cs[5] = c1[1]; cs[6] = c1[2]; cs[7] = c1[3];
        sn[0] = s0[0]; sn[1] = s0[1]; sn[2] = s0[2]; sn[3] = s0[3]; sn[4] = s1v[0]; sn[5] = s1v[1]; sn[6] = s1v[2]; sn[7] = s1v[3];
#pragma unroll
        for (int e = 0; e < 8; ++e) { const int j = ch * 8 + e; const float w = j < C ? 0.08838834764831845f * __builtin_amdgcn_exp2f((float)(C - 1 - j) * lg2) : 0.f;
            o1[e] = (a[e] * cs[e] - bb[e] * sn[e]) * w; o2[e] = (bb[e] * cs[e] + a[e] * sn[e]) * w; }
        *(LAS u32x4*)(sKt + i * TP + ch * 8) = pack8(o1); *(LAS u32x4*)(sKt + (i + 64) * TP + ch * 8) = pack8(o2); } }
    { u32x4 tmp[8];
#pragma unroll
      for (int q = 0; q < 8; ++q) { const int t = tid + q * 512; if (t < (256 << nshift)) { const int dv = t >> nshift, ch = t & (nch - 1); tmp[q] = *(const u32x4*)(UT + (size_t)(UT_VR + h * 256 + dv) * UTP + tokrow0 + ch * 8); } }
#pragma unroll
      for (int q = 0; q < 8; ++q) { const int t = tid + q * 512; if (t < (256 << nshift)) { const int dv = t >> nshift, ch = t & (nch - 1); *(LAS u32x4*)(sVt + dv * TP + ch * 8) = tmp[q]; } } }
    __syncthreads();
    {
        bf16x8 af[4];
#pragma unroll
        for (int ks = 0; ks < 4; ++ks) af[ks] = ks < nks ? *(const LAS bf16x8*)(sKt + (wid * 16 + fr) * TP + ks * 32 + fq * 8) : (bf16x8){0, 0, 0, 0, 0, 0, 0, 0};
#pragma unroll 4
        for (int nt = 0; nt < 16; ++nt) { f32x4 acc = (f32x4){0.f, 0.f, 0.f, 0.f};
#pragma unroll
            for (int ks = 0; ks < 4; ++ks) if (ks < nks) { const bf16x8 bf = *(const LAS bf16x8*)(sVt + (nt * 16 + fr) * TP + ks * 32 + fq * 8); acc = __builtin_amdgcn_mfma_f32_16x16x32_bf16(af[ks], bf, acc, 0, 0, 0); }
            *(f32x4*)(dst + (size_t)(nt * 16 + fr) * 128 + wid * 16 + fq * 4) = acc; }
    }
    __syncthreads();
}

__device__ void ret_sample_item(const Params& p, LAS unsigned char* lds, int item) {
    int tid_ = threadIdx.x; asm volatile("" : "+v"(tid_)); const int tid = tid_, lane = tid & 63, wid = __builtin_amdgcn_readfirstlane(tid >> 6);
    const int h = item & 7, bs = item >> 3;
    const bf16_t* U = (const bf16_t*)(p.ws + OFF_U); bf16_t* Acat = (bf16_t*)(p.ws + OFF_ACAT);
    const float* cosR = (const float*)(p.ws + OFF_COSR); const float* sinR = (const float*)(p.ws + OFF_SINR);
    LAS float* sq = (LAS float*)lds;
    LAS float* sk = sq + 512;
    LAS float* sv = sk + 512;
    LAS float* sdot = sv + 1024;
    LAS float* sred = sdot + 16;
    LAS float* red = sred + 48;
    const float lg2 = lg2_of(h);
    const int dv4 = lane * 4;
    const size_t sbase = ((size_t)(bs * 8 + h) * 128 + wid * 16) * 256 + dv4;
    const float* Sp = p.state + sbase; float* So = p.out + O_RS + sbase;
    f32x4 S[16];
#pragma unroll
    for (int e = 0; e < 16; ++e) S[e] = __builtin_nontemporal_load((const f32x4*)(Sp + (size_t)e * 256));
    {
        const int which = tid >> 8, i = (tid >> 6) & 3, dd = tid & 63;
        const bf16_t* src = U + (size_t)(ROW_S + bs * 4 + i) * NIN + (which ? C_KR : C_QR) + h * 128;
        const float x1 = bf2f(src[dd]), x2 = bf2f(src[dd + 64]);
        const float c = cosR[(4112 + i) * 64 + dd], s = sinR[(4112 + i) * 64 + dd];
        const float sc = which ? 0.08838834764831845f : 1.0f;
        LAS float* d = (which ? sk : sq) + i * 128;
        d[dd] = (x1 * c - x2 * s) * sc; d[dd + 64] = (x2 * c + x1 * s) * sc;
        for (int e = tid; e < 1024; e += 512) { const int ii = e >> 8, dv = e & 255; sv[e] = bf2f(U[(size_t)(ROW_S + bs * 4 + ii) * NIN + C_VR + h * 256 + dv]); }
    }
    __syncthreads();
    {
        const int gi = tid >> 5, l32 = tid & 31, i = gi >> 2, j = gi & 3;
        float s = 0.f;
#pragma unroll
        for (int m = 0; m < 4; ++m) s += sq[i * 128 + l32 + 32 * m] * sk[j * 128 + l32 + 32 * m];
#pragma unroll
        for (int o = 1; o < 32; o <<= 1) s += __shfl_xor(s, o);
        if (l32 == 0) sdot[gi] = s;
    }
    f32x4 vj[4];
#pragma unroll
    for (int j = 0; j < 4; ++j) vj[j] = *(const LAS f32x4*)(sv + j * 256 + dv4);
    const float g1 = __builtin_amdgcn_exp2f(lg2), g2 = g1 * g1, g3 = g2 * g1, g4 = g2 * g2;
    f32x4 qS[4];
#pragma unroll
    for (int i = 0; i < 4; ++i) qS[i] = (f32x4){0.f, 0.f, 0.f, 0.f};
#pragma unroll
    for (int e = 0; e < 16; ++e) { const int dk = wid * 16 + e;
#pragma unroll
        for (int i = 0; i < 4; ++i) qS[i] += sq[i * 128 + dk] * S[e];
        const f32x4 sn = g4 * S[e] + (g3 * sk[dk]) * vj[0] + (g2 * sk[128 + dk]) * vj[1] + (g1 * sk[256 + dk]) * vj[2] + sk[384 + dk] * vj[3];
        __builtin_nontemporal_store(sn, (f32x4*)(So + (size_t)e * 256)); }
#pragma unroll
    for (int i = 0; i < 4; ++i) *(LAS f32x4*)(red + (wid * 4 + i) * 256 + dv4) = qS[i];
    __syncthreads();
    const int i = tid >> 7, dv2 = (tid & 127) * 2;
    float o0 = 0.f, o1 = 0.f;
#pragma unroll
    for (int w = 0; w < 8; ++w) { o0 += red[(w * 4 + i) * 256 + dv2]; o1 += red[(w * 4 + i) * 256 + dv2 + 1]; }
    const float gi1 = __builtin_amdgcn_exp2f((float)(i + 1) * lg2);
    o0 *= gi1; o1 *= gi1;
#pragma unroll
    for (int j = 0; j < 4; ++j) if (j <= i) { const float cf = sdot[i * 4 + j] * __builtin_amdgcn_exp2f((float)(i - j) * lg2); o0 += cf * sv[j * 256 + dv2]; o1 += cf * sv[j * 256 + dv2 + 1]; }
    float s = o0 + o1;
#pragma unroll
    for (int o = 1; o < 64; o <<= 1) s += __shfl_xor(s, o);
    if (lane == 0) sred[wid] = s;
    __syncthreads();
    const float mean = (sred[2 * i] + sred[2 * i + 1]) * (1.0f / 256.0f);
    const float d0 = o0 - mean, d1 = o1 - mean;
    float q = d0 * d0 + d1 * d1;
#pragma unroll
    for (int o = 1; o < 64; o <<= 1) q += __shfl_xor(q, o);
    if (lane == 0) sred[8 + wid] = q;
    __syncthreads();
    const float var = (sred[8 + 2 * i] + sred[8 + 2 * i + 1]) * (1.0f / 256.0f);
    const float rstd = rsqrtf(var + 1e-5f);
    const size_t row = (size_t)(ROW_S + bs * 4 + i); const int cc = h * 256 + dv2;
    const unsigned zw = *(const unsigned*)(U + row * NIN + C_ZR + cc);
    const float y0 = (d0 * rstd * p.gn_g[cc] + p.gn_b[cc]) * siluf_(bf_lo(zw)), y1 = (d1 * rstd * p.gn_g[cc + 1] + p.gn_b[cc + 1]) * siluf_(bf_hi(zw));
    *(unsigned*)(Acat + row * KCAT + 1024 + cc) = cvt_pk_bf16(y0, y1);
    __syncthreads();
}

__device__ void phase3_scan(const Params& p) {
    const int gt = blockIdx.x * 512 + threadIdx.x;
    if (gt >= 131072) return;
    const int b = gt >> 16, h = (gt >> 13) & 7, rem = gt & 8191;
    const float* UcT = (const float*)(p.ws + OFF_UCT); const float* SmT = (const float*)(p.ws + OFF_SMT); bf16_t* SpT = (bf16_t*)(p.ws + OFF_SPT);
    const float g128 = __builtin_amdgcn_exp2f(128.0f * lg2_of(h));
    f32x4 S = *(const f32x4*)(SmT + (size_t)h * 32768 + rem * 4);
    const size_t off0 = ((size_t)(b * 32 * 8 + h)) * 32768 + rem * 4;
    f32x4 ua[8], ub[8];
#pragma unroll
    for (int k = 0; k < 8; ++k) ua[k] = *(const f32x4*)(UcT + off0 + (size_t)k * 262144);
#pragma unroll
    for (int k = 0; k < 8; ++k) ub[k] = *(const f32x4*)(UcT + off0 + (size_t)(8 + k) * 262144);
#pragma unroll
    for (int k = 0; k < 8; ++k) { u32x2 w; w.x = cvt_pk_bf16(S[0], S[1]); w.y = cvt_pk_bf16(S[2], S[3]); *(u32x2*)(SpT + off0 + (size_t)k * 262144) = w; S = g128 * S + ua[k]; }
#pragma unroll
    for (int k = 0; k < 8; ++k) ua[k] = *(const f32x4*)(UcT + off0 + (size_t)(16 + k) * 262144);
#pragma unroll
    for (int k = 0; k < 8; ++k) { u32x2 w; w.x = cvt_pk_bf16(S[0], S[1]); w.y = cvt_pk_bf16(S[2], S[3]); *(u32x2*)(SpT + off0 + (size_t)(8 + k) * 262144) = w; S = g128 * S + ub[k]; }
#pragma unroll
    for (int k = 0; k < 8; ++k) ub[k] = *(const f32x4*)(UcT + off0 + (size_t)(24 + k) * 262144);
#pragma unroll
    for (int k = 0; k < 8; ++k) { u32x2 w; w.x = cvt_pk_bf16(S[0], S[1]); w.y = cvt_pk_bf16(S[2], S[3]); *(u32x2*)(SpT + off0 + (size_t)(16 + k) * 262144) = w; S = g128 * S + ua[k]; }
#pragma unroll
    for (int k = 0; k < 8; ++k) { u32x2 w; w.x = cvt_pk_bf16(S[0], S[1]); w.y = cvt_pk_bf16(S[2], S[3]); *(u32x2*)(SpT + off0 + (size_t)(24 + k) * 262144) = w; S = g128 * S + ub[k]; }
    const int dv = rem >> 5, dk = (rem & 31) * 4;
    float* o = p.out + O_RP + ((size_t)(b * 8 + h) * 128 + dk) * 256 + dv;
    o[0] = S[0]; o[256] = S[1]; o[512] = S[2]; o[768] = S[3];
}

__device__ void ret_out_item(const Params& p, LAS unsigned char* lds, int item) {
    int tid_ = threadIdx.x; asm volatile("" : "+v"(tid_)); const int tid = tid_, lane = tid & 63, wid = __builtin_amdgcn_readfirstlane(tid >> 6), fr = lane & 15, fq = lane >> 4;
    const int h = item & 7, c = (item >> 3) & 31, b = item >> 8;
    const bf16_t* U = (const bf16_t*)(p.ws + OFF_U); const bf16_t* UT = (const bf16_t*)(p.ws + OFF_UT); bf16_t* Acat = (bf16_t*)(p.ws + OFF_ACAT);
    const bf16_t* SpT = (const bf16_t*)(p.ws + OFF_SPT) + (size_t)item * 32768;
    const float* cosR = (const float*)(p.ws + OFF_COSR); const float* sinR = (const float*)(p.ws + OFF_SINR);
    constexpr int TP = 136;
    LAS bf16_t* sK = (LAS bf16_t*)lds; LAS bf16_t* sX = sK + 128 * TP; LAS float* sGN = (LAS float*)(sX + 256 * TP);
    const int tokrow0 = b * 4096 + c * 128, pidx0 = 16 + c * 128;
    sGN[tid] = tid < 256 ? p.gn_g[h * 256 + tid] : p.gn_b[h * 256 + tid - 256];
    const float lg2 = lg2_of(h);
    bf16x8 qf[4];
    { const int i = wid * 16 + fr; const bf16_t* src = U + (size_t)(tokrow0 + i) * NIN + C_QR + h * 128 + fq * 8;
      float x[4][8];
#pragma unroll
      for (int ks = 0; ks < 4; ++ks) { const u32x4 w = *(const u32x4*)(src + ks * 32); unpack8(w, x[ks]); }
#pragma unroll
      for (int ks = 0; ks < 2; ++ks) { const float* cp = cosR + (size_t)(pidx0 + i) * 64 + ks * 32 + fq * 8; const float* sp = sinR + (size_t)(pidx0 + i) * 64 + ks * 32 + fq * 8;
          const f32x4 c0 = *(const f32x4*)cp, c1 = *(const f32x4*)(cp + 4), s0 = *(const f32x4*)sp, s1 = *(const f32x4*)(sp + 4);
#pragma unroll
          for (int e = 0; e < 8; ++e) { const float cs = e < 4 ? c0[e & 3] : c1[e & 3], sn = e < 4 ? s0[e & 3] : s1[e & 3]; const float x1 = x[ks][e], x2 = x[ks + 2][e];
              x[ks][e] = x1 * cs - x2 * sn; x[ks + 2][e] = x2 * cs + x1 * sn; } }
#pragma unroll
      for (int ks = 0; ks < 4; ++ks) qf[ks] = __builtin_bit_cast(bf16x8, pack8(x[ks])); }
#pragma unroll
    for (int q = 0; q < 2; ++q) { const int t = tid + q * 512; const int j = t >> 3, ch = t & 7;
        const bf16_t* src = U + (size_t)(tokrow0 + j) * NIN + C_KR + h * 128 + ch * 8;
        const u32x4 wa = *(const u32x4*)src, wb = *(const u32x4*)(src + 64);
        float a[8], bb[8], o1[8], o2[8]; unpack8(wa, a); unpack8(wb, bb);
        const float* cp = cosR + (size_t)(pidx0 + j) * 64 + ch * 8; const float* sp = sinR + (size_t)(pidx0 + j) * 64 + ch * 8;
        const f32x4 c0 = *(const f32x4*)cp, c1 = *(const f32x4*)(cp + 4), s0 = *(const f32x4*)sp, s1 = *(const f32x4*)(sp + 4);
#pragma unroll
        for (int e = 0; e < 8; ++e) { const float cs = e < 4 ? c0[e & 3] : c1[e & 3], sn = e < 4 ? s0[e & 3] : s1[e & 3];
            o1[e] = (a[e] * cs - bb[e] * sn) * 0.08838834764831845f; o2[e] = (bb[e] * cs + a[e] * sn) * 0.08838834764831845f; }
        *(LAS u32x4*)(sK + j * TP + ch * 8) = pack8(o1); *(LAS u32x4*)(sK + j * TP + 64 + ch * 8) = pack8(o2); }
    { u32x4 tmp[8];
#pragma unroll
      for (int q = 0; q < 8; ++q) { const int t = tid + q * 512; const int dv = t >> 4, ch = t & 15; tmp[q] = *(const u32x4*)(UT + (size_t)(UT_VR + h * 256 + dv) * UTP + tokrow0 + ch * 8); }
#pragma unroll
      for (int q = 0; q < 8; ++q) { const int t = tid + q * 512; const int dv = t >> 4, ch = t & 15; *(LAS u32x4*)(sX + dv * TP + ch * 8) = tmp[q]; } }
    __syncthreads();
    const int iq = wid * 16 + fr;
    bf16x8 pf[4];
#pragma unroll
    for (int k2 = 0; k2 < 4; ++k2) {
        u32x4 pw = (u32x4){0u, 0u, 0u, 0u};
        if (2 * k2 <= wid) {
            f32x4 s0 = (f32x4){0.f, 0.f, 0.f, 0.f}, s1 = (f32x4){0.f, 0.f, 0.f, 0.f};
#pragma unroll
            for (int ks = 0; ks < 4; ++ks) { const bf16x8 k0 = *(const LAS bf16x8*)(sK + (k2 * 32 + fr) * TP + ks * 32 + fq * 8), k1 = *(const LAS bf16x8*)(sK + (k2 * 32 + 16 + fr) * TP + ks * 32 + fq * 8);
                s0 = __builtin_amdgcn_mfma_f32_16x16x32_bf16(k0, qf[ks], s0, 0, 0, 0); s1 = __builtin_amdgcn_mfma_f32_16x16x32_bf16(k1, qf[ks], s1, 0, 0, 0); }
            float v[8];
#pragma unroll
            for (int r = 0; r < 4; ++r) { const int j0 = k2 * 32 + fq * 4 + r, j1 = j0 + 16;
                v[r] = j0 <= iq ? s0[r] * __builtin_amdgcn_exp2f(-(float)(j0 + 1) * lg2) : 0.f; v[4 + r] = j1 <= iq ? s1[r] * __builtin_amdgcn_exp2f(-(float)(j1 + 1) * lg2) : 0.f; }
            pw = pack8(v);
        }
        pf[k2] = __builtin_bit_cast(bf16x8, pw);
    }
    f32x4 o[16];
#pragma unroll
    for (int dt = 0; dt < 16; ++dt) { o[dt] = (f32x4){0.f, 0.f, 0.f, 0.f};
#pragma unroll
        for (int k2 = 0; k2 < 4; ++k2) if (2 * k2 <= wid) { const LAS bf16_t* vr = sX + (dt * 16 + fr) * TP + k2 * 32 + fq * 4;
            const u32x2 lo = *(const LAS u32x2*)vr, hi = *(const LAS u32x2*)(vr + 16); const u32x4 vw = (u32x4){lo.x, lo.y, hi.x, hi.y};
            o[dt] = __builtin_amdgcn_mfma_f32_16x16x32_bf16(__builtin_bit_cast(bf16x8, vw), pf[k2], o[dt], 0, 0, 0); } }
    { u32x4 tmp[8];
#pragma unroll
      for (int q = 0; q < 8; ++q) tmp[q] = *(const u32x4*)(SpT + (size_t)(tid + q * 512) * 8);
      __syncthreads();
#pragma unroll
      for (int q = 0; q < 8; ++q) { const int t = tid + q * 512; const int dv = t >> 4, ch = t & 15; *(LAS u32x4*)(sX + dv * TP + ch * 8) = tmp[q]; } }
    __syncthreads();
    const size_t row = (size_t)(tokrow0 + iq);
    u32x2 zr[16];
#pragma unroll
    for (int dt = 0; dt < 16; ++dt) zr[dt] = *(const u32x2*)(U + row * NIN + C_ZR + h * 256 + dt * 16 + fq * 4);
#pragma unroll
    for (int dt = 0; dt < 16; ++dt)
#pragma unroll
        for (int ks = 0; ks < 4; ++ks) { const bf16x8 sf = *(const LAS bf16x8*)(sX + (dt * 16 + fr) * TP + ks * 32 + fq * 8); o[dt] = __builtin_amdgcn_mfma_f32_16x16x32_bf16(sf, qf[ks], o[dt], 0, 0, 0); }
    const float gi1 = __builtin_amdgcn_exp2f((float)(iq + 1) * lg2);
    float sum = 0.f;
#pragma unroll
    for (int dt = 0; dt < 16; ++dt) { o[dt] *= gi1; sum += (o[dt][0] + o[dt][1]) + (o[dt][2] + o[dt][3]); }
    sum += __shfl_xor(sum, 16); sum += __shfl_xor(sum, 32);
    const float mean = sum * (1.0f / 256.0f);
    float q = 0.f;
#pragma unroll
    for (int dt = 0; dt < 16; ++dt) { o[dt] -= mean; q += (o[dt][0] * o[dt][0] + o[dt][1] * o[dt][1]) + (o[dt][2] * o[dt][2] + o[dt][3] * o[dt][3]); }
    q += __shfl_xor(q, 16); q += __shfl_xor(q, 32);
    const float rstd = rsqrtf(q * (1.0f / 256.0f) + 1e-5f);
#pragma unroll
    for (int dt = 0; dt < 16; ++dt) { const int cc = h * 256 + dt * 16 + fq * 4;
        const f32x4 gg = *(const LAS f32x4*)(sGN + dt * 16 + fq * 4), gb = *(const LAS f32x4*)(sGN + 256 + dt * 16 + fq * 4);
        const u32x2 zw = zr[dt];
        const float y0 = (o[dt][0] * rstd * gg[0] + gb[0]) * siluf_(bf_lo(zw.x)), y1 = (o[dt][1] * rstd * gg[1] + gb[1]) * siluf_(bf_hi(zw.x));
        const float y2 = (o[dt][2] * rstd * gg[2] + gb[2]) * siluf_(bf_lo(zw.y)), y3 = (o[dt][3] * rstd * gg[3] + gb[3]) * siluf_(bf_hi(zw.y));
        u32x2 w; w.x = cvt_pk_bf16(y0, y1); w.y = cvt_pk_bf16(y2, y3);
        *(u32x2*)(Acat + row * KCAT + 1024 + cc) = w; }
    __syncthreads();
}

__global__ void __launch_bounds__(512, 2) mega(Params p) {
    extern __shared__ __attribute__((aligned(16))) unsigned char shm[];
    LAS unsigned char* lds = (LAS unsigned char*)shm;
    cg::grid_group grid = cg::this_grid();
    const int bid = blockIdx.x, nb = gridDim.x;
    unsigned char* ws = p.ws;
#ifndef REP
#define REP 0
#endif
#define PH(n) ((n) >= p.ph_lo && (n) < p.ph_hi)
#define SEAM(n) do { if ((n) + 1 > p.ph_lo && (n) + 1 < p.ph_hi) grid.sync(); } while (0)
#define REPS(n) for (int rep_ = 0; rep_ <= ((REP >> (n)) & 1); ++rep_)
#define RSYNC do { if (rep_) grid.sync(); } while (0)
    if (PH(0)) REPS(0) { RSYNC; phase0(p, lds); }
    SEAM(0);
    if (PH(1)) REPS(1) { RSYNC; pg8::Gemm g{(const bf16_t*)(ws + OFF_XN), (const bf16_t*)(ws + OFF_WINT), MROWS, NIN, DM}; pg8::StaticOrder S; S.init(g.M, g.N, nb, bid);
        EpiU E{(bf16_t*)(ws + OFF_U), (bf16_t*)(ws + OFF_UT)}; pg8::gemm_phase<EpiU>(lds, g, S, E); }
    SEAM(1);
    if (PH(2)) REPS(2) { RSYNC;
        const int n_my = (2312 - bid + nb - 1) / nb;
        for (int k = 0; k < n_my; ++k) { const int it = bid + nb * ((bid & 1) ? n_my - 1 - k : k);
            if (it < 256) attn_prompt_item(p, lds, it);
            else if (it < 776) ret_chunk_item(p, lds, it - 256);
            else if (it < 1288) attn_sample_item(p, lds, it - 776);
            else ret_sample_item(p, lds, it - 1288);
        }
    }
    SEAM(2);
    if (PH(3)) REPS(3) { RSYNC; phase3_scan(p); }
    SEAM(3);
    if (PH(4)) REPS(4) { RSYNC; for (int it = bid; it < 512; it += nb) ret_out_item(p, lds, it); }
    SEAM(4);
    if (PH(5)) REPS(5) { RSYNC; pg8::Gemm g{(const bf16_t*)(ws + OFF_ACAT), (const bf16_t*)(ws + OFF_WCAT), MR2, DM, KCAT}; pg8::StaticOrder S; S.init(g.M, g.N, nb, bid);
        EpiMrg E{(const bf16_t*)(ws + OFF_U), (bf16_t*)(ws + OFF_MRG)}; pg8::gemm_phase<EpiMrg>(lds, g, S, E); }
    SEAM(5);
    if (PH(6)) REPS(6) { RSYNC; pg8::Gemm g{(const bf16_t*)(ws + OFF_MRG), (const bf16_t*)(ws + OFF_WO), MR2, DM, DM}; pg8::StaticOrder S; S.init(g.M, g.N, nb, bid);
        EpiOut E{p.x_prompt, p.x_sample, p.out + O_YP, p.out + O_YS}; pg8::gemm_phase<EpiOut>(lds, g, S, E); }
#undef REPS
#undef RSYNC
#undef PH
#undef SEAM
}

extern "C" void kernel_launch(void* const* d_in, const int* in_sizes, int n_in, void* d_out, int out_size, void* d_ws, size_t ws_size, hipStream_t stream) {
    static int grid = 0;
    if (grid == 0) {
        if (n_in != 16 || ws_size < WS_END) { fprintf(stderr, "kernel_launch: unexpected n_in %d / ws %zu (need %zu)\n", n_in, ws_size, (size_t)WS_END); grid = -1; return; }
        int dev = 0, cus = 0, per_cu = 0;
        hipGetDevice(&dev); hipDeviceGetAttribute(&cus, hipDeviceAttributeMultiprocessorCount, dev);
        if (hipFuncSetAttribute((const void*)mega, hipFuncAttributeMaxDynamicSharedMemorySize, LDS_BYTES) != hipSuccess) { fprintf(stderr, "kernel_launch: hipFuncSetAttribute failed\n"); grid = -1; return; }
        if (hipOccupancyMaxActiveBlocksPerMultiprocessor(&per_cu, (const void*)mega, 512, LDS_BYTES) != hipSuccess || per_cu < 1) { fprintf(stderr, "kernel_launch: occupancy query says %d\n", per_cu); per_cu = 1; (void)hipGetLastError(); }
        grid = cus;
    }
    if (grid < 0) return;
    Params p{};
    p.x_prompt = (const float*)d_in[0]; p.x_sample = (const float*)d_in[1]; p.cache_k = (const float*)d_in[2]; p.cache_v = (const float*)d_in[3]; p.state = (const float*)d_in[4];
    p.meta = (const float*)d_in[5]; p.norm_g = (const float*)d_in[6]; p.w_in = (const float*)d_in[7]; p.q_g = (const float*)d_in[8]; p.k_g = (const float*)d_in[9]; p.sinks = (const float*)d_in[10];
    p.gn_g = (const float*)d_in[11]; p.gn_b = (const float*)d_in[12]; p.w_pa = (const float*)d_in[13]; p.w_pr = (const float*)d_in[14]; p.w_o = (const float*)d_in[15];
    p.out = (float*)d_out; p.ws = (unsigned char*)d_ws; p.ph_lo = 0; p.ph_hi = 7;
    void* args[] = {&p};
    hipError_t e = hipLaunchCooperativeKernel((const void*)mega, dim3(grid), dim3(512), args, LDS_BYTES, stream);
    if (e != hipSuccess) fprintf(stderr, "cooperative launch failed: %s (grid %d)\n", hipGetErrorString(e), grid);
}
```

```cpp
#include <hip/hip_runtime.h>
#include <hip/hip_cooperative_groups.h>
#include <cstdio>
namespace cg = cooperative_groups;
#ifndef REP
#define REP 0
#endif

#define LAS __attribute__((address_space(3)))
typedef unsigned short bf16_t;
typedef short bf16x8 __attribute__((ext_vector_type(8)));
typedef short bf16x4 __attribute__((ext_vector_type(4)));
typedef float f32x4 __attribute__((ext_vector_type(4)));
typedef float f32x2 __attribute__((ext_vector_type(2)));
typedef unsigned u32x4 __attribute__((ext_vector_type(4)));
typedef unsigned u32x2 __attribute__((ext_vector_type(2)));

constexpr int DM = 2048, NIN = 12800, MROWS = 8960, MR2 = 8704, TOKP = 8192, ROW_S = 8192, ROW_M = 8704;
constexpr int C_QA = 0, C_KA = 1024, C_VA = 1280, C_ZA = 1536, C_QR = 2560, C_KR = 3584, C_VR = 4608, C_ZR = 6656, C_GA = 8704, C_GR = 10752;
constexpr int UTP = 8960;
constexpr int UT_VA = 0, UT_KR = 256, UT_VR = 1280;
constexpr int TABP = 4128;
constexpr int KCAT = 3072;
constexpr size_t OFF_XN = 0, OFF_WINT = 36700160, OFF_ACAT = 0, OFF_MRG = 53477376;
constexpr size_t OFF_WCAT = 89128960, OFF_WO = OFF_WCAT + 12582912, OFF_U = OFF_WO + 8388608, OFF_UT = OFF_U + 229376000;
constexpr size_t OFF_UCT = OFF_UT + 59637760, OFF_SMT = OFF_UCT + 67108864, OFF_SPT = OFF_SMT + 1048576, OFF_TAB = OFF_SPT + 33554432;
constexpr size_t OFF_COSA = OFF_TAB, OFF_SINA = OFF_COSA + 132096, OFF_COSR = OFF_SINA + 132096, OFF_SINR = OFF_COSR + 1056768;
constexpr size_t OFF_COSRT = OFF_SINR + 1056768, OFF_SINRT = OFF_COSRT + 1056768, WS_END = OFF_SINRT + 1056768;
constexpr size_t O_YP = 0, O_YS = 16777216, O_WKP = 17825792, O_WVP = 17891328, O_RP = 17956864, O_WKS = 18481152, O_WVS = 22675456, O_RS = 26869760;
constexpr size_t OFF_BAR = (WS_END + 255) & ~(size_t)255, WS_END2 = OFF_BAR + 3456 * 4;
constexpr int LDS_BYTES = 160 * 1024;

struct Params {
    const float *x_prompt, *x_sample, *cache_k, *cache_v, *state, *meta, *norm_g, *w_in, *q_g, *k_g, *sinks, *gn_g, *gn_b, *w_pa, *w_pr, *w_o;
    float* out; unsigned char* ws; int ph_lo, ph_hi;
};

__device__ __forceinline__ unsigned cvt_pk_bf16(float lo, float hi) { unsigned r; asm("v_cvt_pk_bf16_f32 %0, %1, %2" : "=v"(r) : "v"(lo), "v"(hi)); return r; }
__device__ __forceinline__ bf16_t f2bf(float f) { return (bf16_t)(cvt_pk_bf16(f, 0.f) & 0xffffu); }
__device__ __forceinline__ float bf_lo(unsigned w) { return __uint_as_float(w << 16); }
__device__ __forceinline__ float bf_hi(unsigned w) { return __uint_as_float(w & 0xffff0000u); }
__device__ __forceinline__ float bf2f(bf16_t h) { return __uint_as_float(((unsigned)h) << 16); }
__device__ __forceinline__ float fast_exp(float x) { return __builtin_amdgcn_exp2f(x * 1.4426950408889634f); }
__device__ __forceinline__ float sigmoidf_(float x) { return __builtin_amdgcn_rcpf(1.0f + fast_exp(-x)); }
__device__ __forceinline__ float siluf_(float x) { return x * sigmoidf_(x); }
__device__ __forceinline__ float lg2_of(int h) {
    float r = -0.04580368961312479f;
    r = h == 1 ? -0.030662988889756927f : r; r = h == 2 ? -0.020562769581231145f : r; r = h == 3 ? -0.013805413024509017f : r;
    r = h == 4 ? -0.009275800472620728f : r; r = h == 5 ? -0.006235583073184706f : r; r = h == 6 ? -0.004193268921546044f : r;
    r = h == 7 ? -0.002820519062378663f : r; return r;
}
__device__ __forceinline__ void unpack8(u32x4 w, float* x) { x[0] = bf_lo(w.x); x[1] = bf_hi(w.x); x[2] = bf_lo(w.y); x[3] = bf_hi(w.y); x[4] = bf_lo(w.z); x[5] = bf_hi(w.z); x[6] = bf_lo(w.w); x[7] = bf_hi(w.w); }
__device__ __forceinline__ u32x4 pack8(const float* x) { u32x4 w; w.x = cvt_pk_bf16(x[0], x[1]); w.y = cvt_pk_bf16(x[2], x[3]); w.z = cvt_pk_bf16(x[4], x[5]); w.w = cvt_pk_bf16(x[6], x[7]); return w; }
__device__ __forceinline__ int pidx_of_row(int row) { return row < ROW_S ? 16 + (row & 4095) : (row < ROW_M ? 4112 + ((row - ROW_S) & 3) : row - ROW_M); }

namespace pg8 {
constexpr int BM = 256, BK = 64, HALF = 128, HTB = HALF * BK * 2, STAGE_BYTES = 8 * HTB, NXCD = 8, WGM = 8;
__device__ __forceinline__ int lds_byte(int r, int c) { const int st = (r >> 4) * 2 + (c >> 5), rr = r & 15, cc = c & 31, ob = rr * 64 + cc * 2; return st * 1024 + (ob ^ (((ob >> 9) & 1) << 5)); }
__device__ __forceinline__ void stage_rc(int b, int& R, int& C) { const int st = b / 1024, sb = b % 1024, swz = sb ^ (((sb >> 9) & 1) << 5); R = (st >> 1) * 16 + swz / 64; C = (st & 1) * 32 + (swz % 64) / 2; }
__device__ __forceinline__ int perm32(int rho) { const int n = rho >> 4, i = rho & 15; return 8 * (i >> 2) + 4 * n + (i & 3); }
struct Unit { int pm, pn; };
struct Gemm { const bf16_t* A; const bf16_t* Bt; int M, N, K; };
struct StaticOrder {
    int nM, nN, nwg, G, c;
    __device__ void init(int M, int N, int G_, int c_) { nM = M / BM; nN = N / BM; nwg = nM * nN; G = G_; c = c_; }
    __device__ bool next(int i, Unit& u) const {
        const long L = (long)i * G + c; if (L >= nwg) return false;
        int wgid = (int)L; { const int q = nwg / NXCD, r = nwg % NXCD, xcd = wgid % NXCD, off = wgid / NXCD; wgid = (xcd < r ? xcd * (q + 1) : r * (q + 1) + (xcd - r) * q) + off; }
        const int nig = WGM * nN, gid = wgid / nig, fm = gid * WGM, gsz = (nM - fm) < WGM ? (nM - fm) : WGM;
        u.pm = fm + ((wgid % nig) % gsz); u.pn = (wgid % nig) / gsz; return true;
    }
};

template <class Epi>
__device__ __forceinline__ void gemm_phase(LAS unsigned char* lds, const Gemm g, const StaticOrder& S, const Epi& E) {
    const int tid = threadIdx.x, wid = __builtin_amdgcn_readfirstlane(tid >> 6), lane = tid & 63, wr = wid >> 2, wc = wid & 3, fr = lane & 15, fq = lane >> 4;
    const int K = g.K, nt = K / BK;
    unsigned voffA[2], voffB[2];
#pragma unroll
    for (int i = 0; i < 2; ++i) { int R, C; stage_rc(tid * 16 + i * 8192, R, C); const int Rb = Epi::PERM ? ((R & ~31) + perm32(R & 31)) : R;
        voffA[i] = (unsigned)(R * K + C) * 2u; voffB[i] = (unsigned)(Rb * K + C) * 2u; }
    const size_t kstep = (size_t)(BK * 2);
    const size_t hstep = (size_t)HALF * K * 2;
    const size_t tstep = 2 * hstep;
    const unsigned ldsw = (unsigned)wid * 1024u;
    const int aoff = lds_byte(wr * 64 + fr, fq * 8), boff = lds_byte(wc * 32 + fr, fq * 8);
#define PG8_SA(b, h) (((b) * 2 + (h)) * HTB)
#define PG8_SB(b, h) ((4 + (b) * 2 + (h)) * HTB)
#define PG8_STAGE(bufoff, gbase, voff) do { _Pragma("unroll") for (int _i = 0; _i < 2; ++_i) \
        __builtin_amdgcn_global_load_lds((const unsigned*)((const char*)(gbase) + (voff)[_i]), (LAS unsigned*)(lds + (bufoff) + ldsw + _i * 8192), 16, 0, 0); } while (0)
#define PG8_LDA(dst, b, h) do { _Pragma("unroll") for (int m = 0; m < 4; ++m) _Pragma("unroll") for (int k = 0; k < 2; ++k) dst[m][k] = *(const LAS bf16x8*)(lds + PG8_SA(b, h) + aoff + m * 2048 + k * 1024); } while (0)
#define PG8_LDB(dst, b, h) do { _Pragma("unroll") for (int n = 0; n < 2; ++n) _Pragma("unroll") for (int k = 0; k < 2; ++k) dst[n][k] = *(const LAS bf16x8*)(lds + PG8_SB(b, h) + boff + n * 2048 + k * 1024); } while (0)
#define PG8_MMA(ai, bj, At, Bt) do { __builtin_amdgcn_s_setprio(1); _Pragma("unroll") for (int m = 0; m < 4; ++m) _Pragma("unroll") for (int n = 0; n < 2; ++n) _Pragma("unroll") for (int k = 0; k < 2; ++k) \
        acc[ai][bj][m][n] = __builtin_amdgcn_mfma_f32_16x16x32_bf16(Bt[n][k], At[m][k], acc[ai][bj][m][n], 0, 0, 0); __builtin_amdgcn_s_setprio(0); } while (0)
#define PG8_WAIT_V(n) asm volatile("s_waitcnt vmcnt(" #n ")" ::: "memory")
#define PG8_WAIT_L(n) asm volatile("s_waitcnt lgkmcnt(" #n ")" ::: "memory")
#define PG8_BAR __builtin_amdgcn_s_barrier()
#define PG8_SCHED __builtin_amdgcn_sched_barrier(0)
#define PG8_KBODY do { \
            const bool last = (t == nt - 2); \
            const char* a1 = cA + (size_t)(t + 1) * kstep; \
            const char* a2 = last ? nA : cA + (size_t)(t + 2) * kstep; const char* b2 = last ? nB : cB + (size_t)(t + 2) * kstep; \
            const char* a3 = a2 + kstep; const char* b3 = b2 + kstep; \
            PG8_LDB(B0, 0, 0); PG8_SCHED; PG8_LDA(At, 0, 0); PG8_STAGE(PG8_SA(1, 1), a1 + hstep, voffA); \
            PG8_WAIT_L(8); PG8_BAR; PG8_WAIT_L(0); PG8_MMA(0, 0, At, B0); PG8_BAR; PG8_SCHED; \
            PG8_LDB(B1, 0, 1); PG8_STAGE(PG8_SB(0, 0), b2, voffB); \
            PG8_BAR; PG8_WAIT_L(0); PG8_MMA(0, 1, At, B1); PG8_BAR; \
            PG8_LDA(At, 0, 1); PG8_STAGE(PG8_SA(0, 0), a2, voffA); \
            PG8_BAR; PG8_WAIT_L(0); PG8_MMA(1, 0, At, B0); PG8_BAR; PG8_SCHED; \
            PG8_STAGE(PG8_SB(0, 1), b2 + hstep, voffB); \
            PG8_WAIT_V(6); PG8_BAR; PG8_MMA(1, 1, At, B1); PG8_BAR; \
            PG8_LDB(B0, 1, 0); PG8_SCHED; PG8_LDA(At, 1, 0); PG8_STAGE(PG8_SA(0, 1), a2 + hstep, voffA); \
            PG8_WAIT_L(8); PG8_BAR; PG8_WAIT_L(0); PG8_MMA(0, 0, At, B0); PG8_BAR; PG8_SCHED; \
            PG8_LDB(B1, 1, 1); PG8_STAGE(PG8_SB(1, 0), b3, voffB); \
            PG8_BAR; PG8_WAIT_L(0); PG8_MMA(0, 1, At, B1); PG8_BAR; \
            PG8_LDA(At, 1, 1); PG8_STAGE(PG8_SA(1, 0), a3, voffA); \
            PG8_BAR; PG8_WAIT_L(0); PG8_MMA(1, 0, At, B0); PG8_BAR; PG8_SCHED; \
            PG8_STAGE(PG8_SB(1, 1), b3 + hstep, voffB); \
            PG8_WAIT_V(6); PG8_BAR; PG8_MMA(1, 1, At, B1); PG8_BAR; \
        } while (0)
    Unit cur, nxt; int ui = 0;
    if (!S.next(0, cur)) return;
    f32x4 acc[2][2][4][2];
#pragma unroll
    for (int a = 0; a < 2; ++a)
#pragma unroll
        for (int b = 0; b < 2; ++b)
#pragma unroll
            for (int m = 0; m < 4; ++m)
#pragma unroll
                for (int n = 0; n < 2; ++n) acc[a][b][m][n] = (f32x4){0.f, 0.f, 0.f, 0.f};
    bf16x8 At[4][2], B0[2][2], B1[2][2];
    const char* cA = (const char*)g.A + (size_t)cur.pm * tstep; const char* cB = (const char*)g.Bt + (size_t)cur.pn * tstep;
    PG8_STAGE(PG8_SB(0, 0), cB, voffB); PG8_STAGE(PG8_SA(0, 0), cA, voffA); PG8_STAGE(PG8_SB(0, 1), cB + hstep, voffB); PG8_STAGE(PG8_SA(0, 1), cA + hstep, voffA);
    if (wr == 1) PG8_BAR;
    PG8_WAIT_V(4); PG8_BAR;
    PG8_STAGE(PG8_SB(1, 0), cB + kstep, voffB); PG8_STAGE(PG8_SA(1, 0), cA + kstep, voffA); PG8_STAGE(PG8_SB(1, 1), cB + hstep + kstep, voffB);
    PG8_WAIT_V(6); PG8_BAR;
    for (;;) {
        const bool has_next = S.next(ui + 1, nxt);
        const char* nA = has_next ? (const char*)g.A + (size_t)nxt.pm * tstep : cA; const char* nB = has_next ? (const char*)g.Bt + (size_t)nxt.pn * tstep : cB;
        if constexpr (Epi::MID_T > 0) {
            for (int t = 0; t < Epi::MID_T; t += 2) PG8_KBODY;
            E.mid(acc, cur, wr, wc, fr, fq);
            for (int t = Epi::MID_T; t < nt; t += 2) PG8_KBODY;
        } else {
            for (int t = 0; t < nt; t += 2) PG8_KBODY;
        }
        E(acc, cur, wr, wc, fr, fq);
        if constexpr ((REP & 128) != 0 && Epi::MID_T == 0 && Epi::PERM) E(acc, cur, wr, wc, fr, fq);
        if (!has_next) break;
#pragma unroll
        for (int a = 0; a < 2; ++a)
#pragma unroll
            for (int b = 0; b < 2; ++b)
#pragma unroll
                for (int m = 0; m < 4; ++m)
#pragma unroll
                    for (int n = 0; n < 2; ++n) acc[a][b][m][n] = (f32x4){0.f, 0.f, 0.f, 0.f};
        cur = nxt; cA = nA; cB = nB; ++ui;
    }
    PG8_WAIT_V(0);
    if (wr == 0) PG8_BAR;
    PG8_BAR;
#undef PG8_KBODY
#undef PG8_SA
#undef PG8_SB
#undef PG8_STAGE
#undef PG8_LDA
#undef PG8_LDB
#undef PG8_MMA
#undef PG8_WAIT_V
#undef PG8_WAIT_L
#undef PG8_BAR
#undef PG8_SCHED
}
}

struct EpiU {
    static constexpr bool PERM = true; static constexpr int MID_T = 0;
    bf16_t* U; bf16_t* UT;
    __device__ __forceinline__ void operator()(const f32x4 (&acc)[2][2][4][2], const pg8::Unit& u, int wr, int wc, int fr, int fq) const {
        const int row0 = u.pm * 256 + wr * 64 + fr, col0 = u.pn * 256 + wc * 32 + 8 * fq;
#pragma unroll
        for (int ai = 0; ai < 2; ++ai)
#pragma unroll
            for (int m = 0; m < 4; ++m) { bf16_t* rowp = U + (size_t)(row0 + ai * 128 + m * 16) * NIN + col0;
#pragma unroll
                for (int bj = 0; bj < 2; ++bj) { const f32x4 v0 = acc[ai][bj][m][0], v1 = acc[ai][bj][m][1];
                    u32x4 w; w.x = cvt_pk_bf16(v0[0], v0[1]); w.y = cvt_pk_bf16(v0[2], v0[3]); w.z = cvt_pk_bf16(v1[0], v1[1]); w.w = cvt_pk_bf16(v1[2], v1[3]);
                    *(u32x4*)(rowp + bj * 128) = w; } }
        int trow = -1;
        if (u.pn == 5) trow = UT_VA; else if (u.pn >= 14 && u.pn < 18) trow = UT_KR + (u.pn - 14) * 256; else if (u.pn >= 18 && u.pn < 26) trow = UT_VR + (u.pn - 18) * 256;
        if (trow >= 0) {
            bf16_t* base = UT + (size_t)(trow + wc * 32 + 8 * fq) * UTP + row0;
#pragma unroll
            for (int bj = 0; bj < 2; ++bj)
#pragma unroll
                for (int n = 0; n < 2; ++n)
#pragma unroll
                    for (int j = 0; j < 4; ++j) { bf16_t* cp = base + (size_t)(bj * 128 + 4 * n + j) * UTP;
#pragma unroll
                        for (int ai = 0; ai < 2; ++ai)
#pragma unroll
                            for (int m = 0; m < 4; ++m) cp[ai * 128 + m * 16] = f2bf(acc[ai][bj][m][n][j]); }
        }
    }
};
struct EpiMrg {
    static constexpr bool PERM = true; static constexpr int MID_T = 16;
    const bf16_t* U; bf16_t* O;
    __device__ __forceinline__ void mid(f32x4 (&acc)[2][2][4][2], const pg8::Unit& u, int wr, int wc, int fr, int fq) const {
        int row0 = u.pm * 256 + wr * 64 + fr; const int col0 = u.pn * 256 + wc * 32 + 8 * fq;
        asm volatile("" : "+v"(row0));
        const unsigned off0 = ((unsigned)row0 * NIN + col0) * 2u;
        const char* Ub = (const char*)U;
        u32x4 wa[3], wg[3];
#define GOFF(g) (off0 + (unsigned)(((((g) >> 3) * 128 + (((g) >> 1) & 3) * 16) * NIN + ((g) & 1) * 128) * 2))
#pragma unroll
        for (int g = 0; g < 2; ++g) { wa[g] = *(const u32x4*)(Ub + GOFF(g) + C_GA * 2); wg[g] = *(const u32x4*)(Ub + GOFF(g) + C_GR * 2); }
#pragma unroll
        for (int g = 0; g < 16; ++g) {
            if (g + 2 < 16) { wa[(g + 2) % 3] = *(const u32x4*)(Ub + GOFF(g + 2) + C_GA * 2); wg[(g + 2) % 3] = *(const u32x4*)(Ub + GOFF(g + 2) + C_GR * 2); }
            float a[8], r[8]; unpack8(wa[g % 3], a); unpack8(wg[g % 3], r);
#pragma unroll
            for (int e = 0; e < 8; ++e) { const float ratio = (1.0f + fast_exp(-r[e])) * __builtin_amdgcn_rcpf(1.0f + fast_exp(-a[e])); acc[g >> 3][g & 1][(g >> 1) & 3][e >> 2][e & 3] *= ratio; }
            __builtin_amdgcn_sched_barrier(0);
        }
    }
    __device__ __forceinline__ void operator()(const f32x4 (&acc)[2][2][4][2], const pg8::Unit& u, int wr, int wc, int fr, int fq) const {
        int row0 = u.pm * 256 + wr * 64 + fr; const int col0 = u.pn * 256 + wc * 32 + 8 * fq;
        asm volatile("" : "+v"(row0));
        const unsigned off0 = ((unsigned)row0 * NIN + col0) * 2u, ooff0 = ((unsigned)row0 * DM + col0) * 2u;
        const char* Ub = (const char*)U; char* Ob = (char*)O;
        u32x4 wg[16];
#pragma unroll
        for (int g = 0; g < 16; ++g) wg[g] = *(const u32x4*)(Ub + GOFF(g) + C_GR * 2);
#pragma unroll
        for (int g = 0; g < 16; ++g) {
            float r[8], o[8]; unpack8(wg[g], r);
#pragma unroll
            for (int e = 0; e < 8; ++e) o[e] = acc[g >> 3][g & 1][(g >> 1) & 3][e >> 2][e & 3] * sigmoidf_(r[e]);
            *(u32x4*)(Ob + ooff0 + (unsigned)((((g >> 3) * 128 + ((g >> 1) & 3) * 16) * DM + (g & 1) * 128) * 2)) = pack8(o);
        }
#undef GOFF
    }
};
struct EpiOut {
    static constexpr bool PERM = false; static constexpr int MID_T = 0;
    const float* xp; const float* xs; float* yp; float* ys;
    __device__ __forceinline__ void operator()(const f32x4 (&acc)[2][2][4][2], const pg8::Unit& u, int wr, int wc, int fr, int fq) const {
        int row0 = u.pm * 256 + wr * 64 + fr; const int col0 = u.pn * 256 + wc * 32 + 4 * fq;
        asm volatile("" : "+v"(row0));
        const float* xb = u.pm < 32 ? xp : xs - (size_t)TOKP * DM; float* yb = u.pm < 32 ? yp : ys - (size_t)TOKP * DM;
        const unsigned off0 = ((unsigned)row0 * DM + col0) * 4u;
        const char* Xb = (const char*)xb; char* Yb = (char*)yb;
        f32x4 xv[2][4];
#define GOFF(q, k) (off0 + (unsigned)(((((q) >> 2) * 128 + ((q) & 3) * 16) * DM + ((k) >> 1) * 128 + ((k) & 1) * 16) * 4))
#pragma unroll
        for (int k = 0; k < 4; ++k) xv[0][k] = *(const f32x4*)(Xb + GOFF(0, k));
#pragma unroll
        for (int q = 0; q < 8; ++q) {
            if (q + 1 < 8) {
#pragma unroll
                for (int k = 0; k < 4; ++k) xv[(q + 1) & 1][k] = *(const f32x4*)(Xb + GOFF(q + 1, k)); }
#pragma unroll
            for (int k = 0; k < 4; ++k) *(f32x4*)(Yb + GOFF(q, k)) = xv[q & 1][k] + acc[q >> 2][k >> 1][q & 3][k & 1];
            __builtin_amdgcn_sched_barrier(0);
        }
#undef GOFF
    }
};

__device__ __forceinline__ void wtile(const float* W, int N, bf16_t* Wt, int ldt, int koff, int k0, int n0, LAS float* sT, int tid) {
    const int r = tid >> 3, cg = (tid & 7) * 4;
    const float* src = W + (size_t)(k0 + r) * N + n0 + cg;
    f32x4 v[8];
#pragma unroll
    for (int q = 0; q < 8; ++q) v[q] = __builtin_nontemporal_load((const f32x4*)(src + q * 32));
#pragma unroll
    for (int q = 0; q < 8; ++q) { LAS float* d = sT + r * 257 + cg + q * 32; d[0] = v[q][0]; d[1] = v[q][1]; d[2] = v[q][2]; d[3] = v[q][3]; }
    __syncthreads();
    const int nn = tid >> 2, k8 = (tid & 3) * 8;
#pragma unroll
    for (int q = 0; q < 4; ++q) { const int n = nn + q * 128; float o[8];
#pragma unroll
        for (int i = 0; i < 8; ++i) o[i] = sT[(k8 + (q & 1) * 32 + i) * 257 + nn + (q >> 1) * 128];
        (void)n;
        *(u32x4*)(Wt + (size_t)(n0 + nn + (q >> 1) * 128) * ldt + koff + k0 + k8 + (q & 1) * 32) = pack8(o); }
    __syncthreads();
}
__device__ void phase0(const Params& p, LAS unsigned char* lds) {
    const int tid = threadIdx.x, lane = tid & 63, wid = tid >> 6, bid = blockIdx.x, nb = gridDim.x;
    unsigned char* ws = p.ws;
    { float* cosA = (float*)(ws + OFF_COSA); float* sinA = (float*)(ws + OFF_SINA);
      for (int e = bid * 512 + tid; e < 4116 * 8; e += nb * 512) { const int pidx = e >> 3, i = e & 7; const double pos = pidx < 4112 ? (double)pidx : (double)(16384 + pidx - 4112);
          const double inv = exp(-13.122363377404328 * (2.0 * i / 16.0)); double rev = pos * inv * 0.15915494309189535; rev -= rint(rev);
          cosA[e] = __builtin_amdgcn_cosf((float)rev); sinA[e] = __builtin_amdgcn_sinf((float)rev); }
      float* cosR = (float*)(ws + OFF_COSR); float* sinR = (float*)(ws + OFF_SINR); float* cosRT = (float*)(ws + OFF_COSRT); float* sinRT = (float*)(ws + OFF_SINRT);
      for (int e = bid * 512 + tid; e < 4116 * 64; e += nb * 512) { const int pidx = e >> 6, i = e & 63; const double pos = pidx < 4112 ? (double)pidx : (double)(16384 + pidx - 4112);
          const double inv = exp(-9.210340371976182 * (2.0 * i / 128.0)); double rev = pos * inv * 0.15915494309189535; rev -= rint(rev);
          const float c = __builtin_amdgcn_cosf((float)rev), s = __builtin_amdgcn_sinf((float)rev);
          cosR[e] = c; sinR[e] = s; cosRT[i * TABP + pidx] = c; sinRT[i * TABP + pidx] = s; } }
    { bf16_t* Xn = (bf16_t*)(ws + OFF_XN);
      for (int row = bid * 8 + wid; row < MROWS; row += nb * 8) {
          bf16_t* dst = Xn + (size_t)row * DM;
          const float* src = row < ROW_S ? p.x_prompt + (size_t)row * DM : (row < ROW_M ? p.x_sample + (size_t)(row - ROW_S) * DM : (row < ROW_M + 16 ? p.meta + (size_t)(row - ROW_M) * DM : nullptr));
          if (!src) {
#pragma unroll
              for (int i = 0; i < 4; ++i) *(u32x4*)(dst + (i * 64 + lane) * 8) = (u32x4){0u, 0u, 0u, 0u};
              continue; }
          f32x4 v[8]; float ss = 0.f;
#pragma unroll
          for (int i = 0; i < 8; ++i) { v[i] = *(const f32x4*)(src + (i * 64 + lane) * 4); ss += v[i][0] * v[i][0] + v[i][1] * v[i][1] + v[i][2] * v[i][2] + v[i][3] * v[i][3]; }
#pragma unroll
          for (int o = 1; o < 64; o <<= 1) ss += __shfl_xor(ss, o);
          const float rs = rsqrtf(ss * (1.0f / 2048.0f) + 1e-6f);
#pragma unroll
          for (int i = 0; i < 8; ++i) { const f32x4 g = *(const f32x4*)(p.norm_g + (i * 64 + lane) * 4);
              u32x2 w; w.x = cvt_pk_bf16(v[i][0] * rs * g[0], v[i][1] * rs * g[1]); w.y = cvt_pk_bf16(v[i][2] * rs * g[2], v[i][3] * rs * g[3]);
              *(u32x2*)(dst + (i * 64 + lane) * 4) = w; }
      } }
    { LAS float* sT = (LAS float*)lds;
      bf16_t* WinT = (bf16_t*)(ws + OFF_WINT); bf16_t* WcatT = (bf16_t*)(ws + OFF_WCAT); bf16_t* WoT = (bf16_t*)(ws + OFF_WO);
      for (int t = bid; t < 2240; t += nb) {
          if (t < 1600) { const int kt = t / 50, ntile = t % 50; wtile(p.w_in, NIN, WinT, DM, 0, kt * 64, ntile * 256, sT, tid); }
          else if (t < 1728) { const int q = t - 1600, kt = q >> 3, ntile = q & 7; wtile(p.w_pa, DM, WcatT, KCAT, 0, kt * 64, ntile * 256, sT, tid); }
          else if (t < 1984) { const int q = t - 1728, kt = q >> 3, ntile = q & 7; wtile(p.w_pr, DM, WcatT, KCAT, 1024, kt * 64, ntile * 256, sT, tid); }
          else { const int q = t - 1984, kt = q >> 3, ntile = q & 7; wtile(p.w_o, DM, WoT, DM, 0, kt * 64, ntile * 256, sT, tid); }
      } }
}

__device__ __forceinline__ void headnorm_rope(float (&x)[64], const LAS float* gain, const float* __restrict__ cs, const float* __restrict__ sn, float scale) {
    float ss = 0.f;
#pragma unroll
    for (int d = 0; d < 64; ++d) ss += x[d] * x[d];
    const float rs = rsqrtf(ss * (1.0f / 64.0f) + 1e-6f);
#pragma unroll
    for (int d4 = 0; d4 < 16; ++d4) { const f32x4 g = *(const LAS f32x4*)(gain + d4 * 4); x[d4 * 4] *= rs * g[0]; x[d4 * 4 + 1] *= rs * g[1]; x[d4 * 4 + 2] *= rs * g[2]; x[d4 * 4 + 3] *= rs * g[3]; }
#pragma unroll
    for (int i = 0; i < 8; ++i) { const float c = cs[i], s = sn[i], x1 = x[i], x2 = x[i + 8]; x[i] = x1 * c - x2 * s; x[i + 8] = x2 * c + x1 * s; }
#pragma unroll
    for (int d = 0; d < 64; ++d) x[d] *= scale;
}
__device__ __forceinline__ void load_row64_bf16(const bf16_t* src, float (&x)[64]) {
#pragma unroll
    for (int c = 0; c < 8; ++c) { const u32x4 w = *(const u32x4*)(src + c * 8); unpack8(w, &x[c * 8]); }
}
__device__ __forceinline__ void load_row64_f32(const float* src, float (&x)[64]) {
#pragma unroll
    for (int c = 0; c < 16; ++c) { const f32x4 w = *(const f32x4*)(src + c * 4); x[c * 4] = w[0]; x[c * 4 + 1] = w[1]; x[c * 4 + 2] = w[2]; x[c * 4 + 3] = w[3]; }
}
__device__ __forceinline__ void store_row64_lds(LAS bf16_t* dst, const float (&x)[64]) {
#pragma unroll
    for (int c = 0; c < 8; ++c) *(LAS u32x4*)(dst + c * 8) = pack8(&x[c * 8]);
}
__device__ __forceinline__ void store_row64_f32(float* dst, const float (&x)[64]) {
#pragma unroll
    for (int c = 0; c < 16; ++c) *(f32x4*)(dst + c * 4) = (f32x4){x[c * 4], x[c * 4 + 1], x[c * 4 + 2], x[c * 4 + 3]};
}
template <int NKT, class MaskF>
__device__ __forceinline__ void attn_tile16(const LAS bf16_t* sQ, int qp, const LAS bf16_t* sK, int kp, const LAS bf16_t* sVt, int vp, float sinkv, MaskF mask, f32x4 (&o)[4], int lane) {
    const int fr = lane & 15, fq = lane >> 4;
    bf16x8 qf[2];
#pragma unroll
    for (int ks = 0; ks < 2; ++ks) qf[ks] = *(const LAS bf16x8*)(sQ + fr * qp + ks * 32 + fq * 8);
    f32x4 s[NKT];
#pragma unroll
    for (int kt = 0; kt < NKT; ++kt) { s[kt] = (f32x4){0.f, 0.f, 0.f, 0.f};
#pragma unroll
        for (int ks = 0; ks < 2; ++ks) { const bf16x8 kf = *(const LAS bf16x8*)(sK + (kt * 16 + fr) * kp + ks * 32 + fq * 8); s[kt] = __builtin_amdgcn_mfma_f32_16x16x32_bf16(kf, qf[ks], s[kt], 0, 0, 0); } }
    float mx = sinkv;
#pragma unroll
    for (int kt = 0; kt < NKT; ++kt)
#pragma unroll
        for (int r = 0; r < 4; ++r) { const float v = mask(kt * 16 + fq * 4 + r) ? s[kt][r] : -1e30f; s[kt][r] = v; mx = fmaxf(mx, v); }
    mx = fmaxf(mx, __shfl_xor(mx, 16)); mx = fmaxf(mx, __shfl_xor(mx, 32));
    float sum = 0.f;
#pragma unroll
    for (int kt = 0; kt < NKT; ++kt)
#pragma unroll
        for (int r = 0; r < 4; ++r) { const float pe = fast_exp(s[kt][r] - mx); s[kt][r] = pe; sum += pe; }
    sum += __shfl_xor(sum, 16); sum += __shfl_xor(sum, 32);
    sum += fast_exp(sinkv - mx);
    const float inv = 1.0f / sum;
#pragma unroll
    for (int dt = 0; dt < 4; ++dt) o[dt] = (f32x4){0.f, 0.f, 0.f, 0.f};
#pragma unroll
    for (int k2 = 0; k2 < NKT / 2; ++k2) {
        u32x4 pw; pw.x = cvt_pk_bf16(s[2 * k2][0], s[2 * k2][1]); pw.y = cvt_pk_bf16(s[2 * k2][2], s[2 * k2][3]); pw.z = cvt_pk_bf16(s[2 * k2 + 1][0], s[2 * k2 + 1][1]); pw.w = cvt_pk_bf16(s[2 * k2 + 1][2], s[2 * k2 + 1][3]);
        const bf16x8 pf = __builtin_bit_cast(bf16x8, pw);
#pragma unroll
        for (int dt = 0; dt < 4; ++dt) { const LAS bf16_t* vr = sVt + (dt * 16 + fr) * vp + k2 * 32 + fq * 4;
            const u32x2 lo = *(const LAS u32x2*)vr, hi = *(const LAS u32x2*)(vr + 16);
            const u32x4 vw = (u32x4){lo.x, lo.y, hi.x, hi.y};
            o[dt] = __builtin_amdgcn_mfma_f32_16x16x32_bf16(__builtin_bit_cast(bf16x8, vw), pf, o[dt], 0, 0, 0); }
    }
#pragma unroll
    for (int dt = 0; dt < 4; ++dt) o[dt] *= inv;
}

__device__ void attn_prompt_item(const Params& p, LAS unsigned char* lds, int item) {
    int tid_ = threadIdx.x; asm volatile("" : "+v"(tid_)); const int tid = tid_, lane = tid & 63, wid = __builtin_amdgcn_readfirstlane(tid >> 6);
    const int kvh = item & 3, blk = (item >> 2) & 31, b = item >> 7;
    const bf16_t* U = (const bf16_t*)(p.ws + OFF_U); const bf16_t* UT = (const bf16_t*)(p.ws + OFF_UT); bf16_t* Acat = (bf16_t*)(p.ws + OFF_ACAT);
    const float* cosA = (const float*)(p.ws + OFF_COSA); const float* sinA = (const float*)(p.ws + OFF_SINA);
    constexpr int QP = 72, KP = 72, VP = 296;
    LAS bf16_t* sQ = (LAS bf16_t*)lds; LAS bf16_t* sK = sQ + 512 * QP; LAS bf16_t* sVt = sK + 288 * KP; LAS float* sG = (LAS float*)(sVt + 64 * VP);
    const int tok0 = blk * 128;
    if (tid < 128) sG[tid] = tid < 64 ? p.q_g[tid] : p.k_g[tid - 64];
    __syncthreads();
    {
        const int g = tid >> 7, tok = tid & 127; const int row = b * 4096 + tok0 + tok; const int pidx = 16 + tok0 + tok;
        float x[64]; load_row64_bf16(U + (size_t)row * NIN + C_QA + (kvh * 4 + g) * 64, x);
        headnorm_rope(x, sG, cosA + pidx * 8, sinA + pidx * 8, 0.125f);
        store_row64_lds(sQ + tid * QP, x);
    }
    __builtin_amdgcn_sched_barrier(0);
    if (tid < 288) {
        float x[64];
        int row = -1, pidx = 0;
        if (tid < 16) { row = ROW_M + tid; pidx = tid; }
        else if (tid < 272) { const int tk = tok0 - 128 + (tid - 16); if (tk >= 0) { row = b * 4096 + tk; pidx = 16 + tk; } }
        if (row >= 0) { load_row64_bf16(U + (size_t)row * NIN + C_KA + kvh * 64, x); headnorm_rope(x, sG + 64, cosA + pidx * 8, sinA + pidx * 8, 1.0f); }
        else {
#pragma unroll
            for (int d = 0; d < 64; ++d) x[d] = 0.f; }
        store_row64_lds(sK + tid * KP, x);
        if (blk == 31 && tid >= 144 && tid < 272) store_row64_f32(p.out + O_WKP + ((size_t)(b * 128 + (tid - 144)) * 4 + kvh) * 64, x);
    }
    { u32x4 tmp[5];
#pragma unroll
      for (int q = 0; q < 5; ++q) { const int c = tid + q * 512; tmp[q] = (u32x4){0u, 0u, 0u, 0u};
        if (c < 64 * 37) { const int d = c / 37, ch = c % 37; const bf16_t* src = UT + (size_t)(UT_VA + kvh * 64 + d) * UTP;
          if (ch < 2) tmp[q] = *(const u32x4*)(src + ROW_M + ch * 8);
          else if (ch < 34) { const int tk = tok0 - 128 + (ch - 2) * 8; if (tk >= 0) tmp[q] = *(const u32x4*)(src + b * 4096 + tk); } } }
#pragma unroll
      for (int q = 0; q < 5; ++q) { const int c = tid + q * 512; if (c < 64 * 37) { const int d = c / 37, ch = c % 37; *(LAS u32x4*)(sVt + d * VP + ch * 8) = tmp[q]; } } }
    if (blk == 31) { u32x4 tmp[2];
#pragma unroll
      for (int q = 0; q < 2; ++q) { const int e = tid + q * 512; const int tk = e >> 3, d8 = (e & 7) * 8; tmp[q] = *(const u32x4*)(U + (size_t)(b * 4096 + 3968 + tk) * NIN + C_VA + kvh * 64 + d8); }
#pragma unroll
      for (int q = 0; q < 2; ++q) { const int e = tid + q * 512; const int tk = e >> 3, d8 = (e & 7) * 8; float x[8]; unpack8(tmp[q], x);
        float* o = p.out + O_WVP + ((size_t)(b * 128 + tk) * 4 + kvh) * 64 + d8; *(f32x4*)o = (f32x4){x[0], x[1], x[2], x[3]}; *(f32x4*)(o + 4) = (f32x4){x[4], x[5], x[6], x[7]}; } }
    __syncthreads();
    const int g = wid >> 1, half = wid & 1, fr = lane & 15, fq = lane >> 4;
    const float sinkv = p.sinks[kvh * 4 + g];
#pragma unroll 1
    for (int mt_ = 0; mt_ < 4; ++mt_) {
        int mt = mt_; asm volatile("" : "+s"(mt));
        const int qi = half * 64 + mt * 16 + fr;
        f32x4 o[4];
        auto mask = [&](int kidx) -> bool { const int kj = kidx - 144; return kidx < 16 || (kidx < 272 && kj <= qi && kj > qi - 128 && tok0 + kj >= 0); };
        const size_t row = (size_t)(b * 4096 + tok0 + qi); const int hc = (kvh * 4 + g) * 64;
        u32x2 zq[4];
#pragma unroll
        for (int dt = 0; dt < 4; ++dt) zq[dt] = *(const u32x2*)(U + row * NIN + C_ZA + hc + dt * 16 + fq * 4);
        attn_tile16<18>(sQ + (g * 128 + half * 64 + mt * 16) * QP, QP, sK, KP, sVt, VP, sinkv, mask, o, lane);
#pragma unroll
        for (int dt = 0; dt < 4; ++dt) { const int d = dt * 16 + fq * 4;
            const u32x2 zw = zq[dt];
            u32x2 w; w.x = cvt_pk_bf16(o[dt][0] * siluf_(bf_lo(zw.x)), o[dt][1] * siluf_(bf_hi(zw.x))); w.y = cvt_pk_bf16(o[dt][2] * siluf_(bf_lo(zw.y)), o[dt][3] * siluf_(bf_hi(zw.y)));
            *(u32x2*)(Acat + row * KCAT + hc + d) = w; }
    }
    __syncthreads();
}

__device__ void attn_sample_item(const Params& p, LAS unsigned char* lds, int item) {
    int tid_ = threadIdx.x; asm volatile("" : "+v"(tid_)); const int tid = tid_, lane = tid & 63, wid = __builtin_amdgcn_readfirstlane(tid >> 6);
    const int kvh = item & 3, bs = item >> 2;
    const bf16_t* U = (const bf16_t*)(p.ws + OFF_U); const bf16_t* UT = (const bf16_t*)(p.ws + OFF_UT); bf16_t* Acat = (bf16_t*)(p.ws + OFF_ACAT);
    const float* cosA = (const float*)(p.ws + OFF_COSA); const float* sinA = (const float*)(p.ws + OFF_SINA);
    constexpr int QP = 72, KP = 72, VP = 168;
    LAS bf16_t* sQ = (LAS bf16_t*)lds; LAS bf16_t* sK = sQ + 16 * QP; LAS bf16_t* sVt = sK + 160 * KP; LAS float* sG = (LAS float*)(sVt + 64 * VP);
    if (tid < 128) sG[tid] = tid < 64 ? p.q_g[tid] : p.k_g[tid - 64];
    __syncthreads();
    if (tid < 160) {
        float x[64];
        if (tid < 16) { load_row64_bf16(U + (size_t)(ROW_M + tid) * NIN + C_KA + kvh * 64, x); headnorm_rope(x, sG + 64, cosA + tid * 8, sinA + tid * 8, 1.0f); }
        else if (tid < 144) { const int c = tid - 16; load_row64_f32(p.cache_k + ((size_t)(bs * 128 + c) * 4 + kvh) * 64, x);
            if (c >= 4) store_row64_f32(p.out + O_WKS + ((size_t)(bs * 128 + c - 4) * 4 + kvh) * 64, x); }
        else if (tid < 148) { const int i = tid - 144; load_row64_bf16(U + (size_t)(ROW_S + bs * 4 + i) * NIN + C_KA + kvh * 64, x);
            headnorm_rope(x, sG + 64, cosA + (4112 + i) * 8, sinA + (4112 + i) * 8, 1.0f);
            store_row64_f32(p.out + O_WKS + ((size_t)(bs * 128 + 124 + i) * 4 + kvh) * 64, x); }
        else {
#pragma unroll
            for (int d = 0; d < 64; ++d) x[d] = 0.f; }
        store_row64_lds(sK + tid * KP, x);
    } else if (tid >= 192 && tid < 208) {
        const int r = tid - 192, g = r >> 2, i = r & 3;
        float x[64]; load_row64_bf16(U + (size_t)(ROW_S + bs * 4 + i) * NIN + C_QA + (kvh * 4 + g) * 64, x);
        headnorm_rope(x, sG, cosA + (4112 + i) * 8, sinA + (4112 + i) * 8, 0.125f);
        store_row64_lds(sQ + r * QP, x);
    }
    { float xv[3][8];
#pragma unroll
      for (int q = 0; q < 3; ++q) { const int t = tid + q * 512; const int key = t >> 3, d8 = (t & 7) * 8;
#pragma unroll
        for (int e = 0; e < 8; ++e) xv[q][e] = 0.f;
        if (t < 168 * 8) {
          if (key < 16) { const u32x4 w = *(const u32x4*)(U + (size_t)(ROW_M + key) * NIN + C_VA + kvh * 64 + d8); unpack8(w, xv[q]); }
          else if (key < 144) { const float* s = p.cache_v + ((size_t)(bs * 128 + key - 16) * 4 + kvh) * 64 + d8; const f32x4 a = *(const f32x4*)s, c = *(const f32x4*)(s + 4);
              xv[q][0] = a[0]; xv[q][1] = a[1]; xv[q][2] = a[2]; xv[q][3] = a[3]; xv[q][4] = c[0]; xv[q][5] = c[1]; xv[q][6] = c[2]; xv[q][7] = c[3]; }
          else if (key < 148) { const u32x4 w = *(const u32x4*)(U + (size_t)(ROW_S + bs * 4 + key - 144) * NIN + C_VA + kvh * 64 + d8); unpack8(w, xv[q]); } } }
#pragma unroll
      for (int q = 0; q < 3; ++q) { const int t = tid + q * 512; const int key = t >> 3, d8 = (t & 7) * 8;
        if (t < 168 * 8) {
#pragma unroll
          for (int e = 0; e < 8; ++e) sVt[(d8 + e) * VP + key] = f2bf(xv[q][e]);
          if (key >= 20 && key < 148) { float* o = p.out + O_WVS + ((size_t)(bs * 128 + key - 20) * 4 + kvh) * 64 + d8;
              *(f32x4*)o = (f32x4){xv[q][0], xv[q][1], xv[q][2], xv[q][3]}; *(f32x4*)(o + 4) = (f32x4){xv[q][4], xv[q][5], xv[q][6], xv[q][7]}; } } } }
    __syncthreads();
    if (wid == 0) {
        const int fr = lane & 15, fq = lane >> 4, g = fr >> 2, i = fr & 3;
        const float sinkv = p.sinks[kvh * 4 + g];
        f32x4 o[4];
        auto mask = [&](int kidx) -> bool { return kidx < 16 || (kidx < 144 ? (kidx - 16) > i : (kidx < 148 && (kidx - 144) <= i)); };
        attn_tile16<10>(sQ, QP, sK, KP, sVt, VP, sinkv, mask, o, lane);
        const size_t row = (size_t)(ROW_S + bs * 4 + i); const int hc = (kvh * 4 + g) * 64;
        u32x2 zq[4];
#pragma unroll
        for (int dt = 0; dt < 4; ++dt) zq[dt] = *(const u32x2*)(U + row * NIN + C_ZA + hc + dt * 16 + fq * 4);
#pragma unroll
        for (int dt = 0; dt < 4; ++dt) { const int d = dt * 16 + fq * 4;
            const u32x2 zw = zq[dt];
            u32x2 w; w.x = cvt_pk_bf16(o[dt][0] * siluf_(bf_lo(zw.x)), o[dt][1] * siluf_(bf_hi(zw.x))); w.y = cvt_pk_bf16(o[dt][2] * siluf_(bf_lo(zw.y)), o[dt][3] * siluf_(bf_hi(zw.y)));
            *(u32x2*)(Acat + row * KCAT + hc + d) = w; }
    }
    __syncthreads();
}

__device__ void ret_chunk_item(const Params& p, LAS unsigned char* lds, int item) {
    int tid_ = threadIdx.x; asm volatile("" : "+v"(tid_)); const int tid = tid_, lane = tid & 63, wid = __builtin_amdgcn_readfirstlane(tid >> 6), fr = lane & 15, fq = lane >> 4;
    const bf16_t* UT = (const bf16_t*)(p.ws + OFF_UT);
    const float* cosRT = (const float*)(p.ws + OFF_COSRT); const float* sinRT = (const float*)(p.ws + OFF_SINRT);
    int h, tokrow0, pidx0, C, nks; float* dst;
    if (item < 512) { h = item & 7; const int c = (item >> 3) & 31, b = item >> 8; tokrow0 = b * 4096 + c * 128; pidx0 = 16 + c * 128; C = 128; nks = 4; dst = (float*)(p.ws + OFF_UCT) + (size_t)item * 32768; }
    else { h = item - 512; tokrow0 = ROW_M; pidx0 = 0; C = 16; nks = 1; dst = (float*)(p.ws + OFF_SMT) + (size_t)h * 32768; }
    const int ntok = nks * 32;
    constexpr int TP = 136;
    LAS bf16_t* sKt = (LAS bf16_t*)lds; LAS bf16_t* sVt = sKt + 128 * TP;
    const float lg2 = lg2_of(h);
    const int nshift = nks == 4 ? 4 : 2, nch = 1 << nshift;
#pragma unroll
    for (int q = 0; q < 2; ++q) { const int t = tid + q * 512; if (t < (64 << nshift)) { const int i = t >> nshift, ch = t & (nch - 1);
        const bf16_t* s1 = UT + (size_t)(UT_KR + h * 128 + i) * UTP + tokrow0 + ch * 8;
        const u32x4 wa = *(const u32x4*)s1, wb = *(const u32x4*)(s1 + (size_t)64 * UTP);
        float a[8], bb[8], cs[8], sn[8], o1[8], o2[8]; unpack8(wa, a); unpack8(wb, bb);
        const float* cp = cosRT + i * TABP + pidx0 + ch * 8; const float* sp = sinRT + i * TABP + pidx0 + ch * 8;
        const f32x4 c0 = *(const f32x4*)cp, c1 = *(const f32x4*)(cp + 4), s0 = *(const f32x4*)sp, s1v = *(const f32x4*)(sp + 4);
        cs[0] = c0[0]; cs[1] = c0[1]; cs[2] = c0[2]; cs[3] = c0[3]; cs[4] = c1[0]; cs[5] = c1[1]; cs[6] = c1[2]; cs[7] = c1[3];
        sn[0] = s0[0]; sn[1] = s0[1]; sn[2] = s0[2]; sn[3] = s0[3]; sn[4] = s1v[0]; sn[5] = s1v[1]; sn[6] = s1v[2]; sn[7] = s1v[3];
#pragma unroll
        for (int e = 0; e < 8; ++e) { const int j = ch * 8 + e; const float w = j < C ? 0.08838834764831845f * __builtin_amdgcn_exp2f((float)(C - 1 - j) * lg2) : 0.f;
            o1[e] = (a[e] * cs[e] - bb[e] * sn[e]) * w; o2[e] = (bb[e] * cs[e] + a[e] * sn[e]) * w; }
        *(LAS u32x4*)(sKt + i * TP + ch * 8) = pack8(o1); *(LAS u32x4*)(sKt + (i + 64) * TP + ch * 8) = pack8(o2); } }
    { u32x4 tmp[8];
#pragma unroll
      for (int q = 0; q < 8; ++q) { const int t = tid + q * 512; if (t < (256 << nshift)) { const int dv = t >> nshift, ch = t & (nch - 1); tmp[q] = *(const u32x4*)(UT + (size_t)(UT_VR + h * 256 + dv) * UTP + tokrow0 + ch * 8); } }
#pragma unroll
      for (int q = 0; q < 8; ++q) { const int t = tid + q * 512; if (t < (256 << nshift)) { const int dv = t >> nshift, ch = t & (nch - 1); *(LAS u32x4*)(sVt + dv * TP + ch * 8) = tmp[q]; } } }
    __syncthreads();
    {
        bf16x8 af[4];
#pragma unroll
        for (int ks = 0; ks < 4; ++ks) af[ks] = ks < nks ? *(const LAS bf16x8*)(sKt + (wid * 16 + fr) * TP + ks * 32 + fq * 8) : (bf16x8){0, 0, 0, 0, 0, 0, 0, 0};
#pragma unroll 4
        for (int nt = 0; nt < 16; ++nt) { f32x4 acc = (f32x4){0.f, 0.f, 0.f, 0.f};
#pragma unroll
            for (int ks = 0; ks < 4; ++ks) if (ks < nks) { const bf16x8 bf = *(const LAS bf16x8*)(sVt + (nt * 16 + fr) * TP + ks * 32 + fq * 8); acc = __builtin_amdgcn_mfma_f32_16x16x32_bf16(af[ks], bf, acc, 0, 0, 0); }
            *(f32x4*)(dst + (size_t)(nt * 16 + fr) * 128 + wid * 16 + fq * 4) = acc; }
    }
    __syncthreads();
}

__device__ void ret_sample_item(const Params& p, LAS unsigned char* lds, int item) {
    int tid_ = threadIdx.x; asm volatile("" : "+v"(tid_)); const int tid = tid_, lane = tid & 63, wid = __builtin_amdgcn_readfirstlane(tid >> 6);
    const int h = item & 7, bs = item >> 3;
    const bf16_t* U = (const bf16_t*)(p.ws + OFF_U); bf16_t* Acat = (bf16_t*)(p.ws + OFF_ACAT);
    const float* cosR = (const float*)(p.ws + OFF_COSR); const float* sinR = (const float*)(p.ws + OFF_SINR);
    LAS float* sq = (LAS float*)lds;
    LAS float* sk = sq + 512;
    LAS float* sv = sk + 512;
    LAS float* sdot = sv + 1024;
    LAS float* sred = sdot + 16;
    LAS float* red = sred + 48;
    const float lg2 = lg2_of(h);
    const int dv4 = lane * 4;
    const size_t sbase = ((size_t)(bs * 8 + h) * 128 + wid * 16) * 256 + dv4;
    const float* Sp = p.state + sbase; float* So = p.out + O_RS + sbase;
    f32x4 S[16];
#pragma unroll
    for (int e = 0; e < 16; ++e) S[e] = __builtin_nontemporal_load((const f32x4*)(Sp + (size_t)e * 256));
    {
        const int which = tid >> 8, i = (tid >> 6) & 3, dd = tid & 63;
        const bf16_t* src = U + (size_t)(ROW_S + bs * 4 + i) * NIN + (which ? C_KR : C_QR) + h * 128;
        const float x1 = bf2f(src[dd]), x2 = bf2f(src[dd + 64]);
        const float c = cosR[(4112 + i) * 64 + dd], s = sinR[(4112 + i) * 64 + dd];
        const float sc = which ? 0.08838834764831845f : 1.0f;
        LAS float* d = (which ? sk : sq) + i * 128;
        d[dd] = (x1 * c - x2 * s) * sc; d[dd + 64] = (x2 * c + x1 * s) * sc;
        for (int e = tid; e < 1024; e += 512) { const int ii = e >> 8, dv = e & 255; sv[e] = bf2f(U[(size_t)(ROW_S + bs * 4 + ii) * NIN + C_VR + h * 256 + dv]); }
    }
    __syncthreads();
    {
        const int gi = tid >> 5, l32 = tid & 31, i = gi >> 2, j = gi & 3;
        float s = 0.f;
#pragma unroll
        for (int m = 0; m < 4; ++m) s += sq[i * 128 + l32 + 32 * m] * sk[j * 128 + l32 + 32 * m];
#pragma unroll
        for (int o = 1; o < 32; o <<= 1) s += __shfl_xor(s, o);
        if (l32 == 0) sdot[gi] = s;
    }
    f32x4 vj[4];
#pragma unroll
    for (int j = 0; j < 4; ++j) vj[j] = *(const LAS f32x4*)(sv + j * 256 + dv4);
    const float g1 = __builtin_amdgcn_exp2f(lg2), g2 = g1 * g1, g3 = g2 * g1, g4 = g2 * g2;
    f32x4 qS[4];
#pragma unroll
    for (int i = 0; i < 4; ++i) qS[i] = (f32x4){0.f, 0.f, 0.f, 0.f};
#pragma unroll
    for (int e = 0; e < 16; ++e) { const int dk = wid * 16 + e;
#pragma unroll
        for (int i = 0; i < 4; ++i) qS[i] += sq[i * 128 + dk] * S[e];
        const f32x4 sn = g4 * S[e] + (g3 * sk[dk]) * vj[0] + (g2 * sk[128 + dk]) * vj[1] + (g1 * sk[256 + dk]) * vj[2] + sk[384 + dk] * vj[3];
        __builtin_nontemporal_store(sn, (f32x4*)(So + (size_t)e * 256)); }
#pragma unroll
    for (int i = 0; i < 4; ++i) *(LAS f32x4*)(red + (wid * 4 + i) * 256 + dv4) = qS[i];
    __syncthreads();
    const int i = tid >> 7, dv2 = (tid & 127) * 2;
    float o0 = 0.f, o1 = 0.f;
#pragma unroll
    for (int w = 0; w < 8; ++w) { o0 += red[(w * 4 + i) * 256 + dv2]; o1 += red[(w * 4 + i) * 256 + dv2 + 1]; }
    const float gi1 = __builtin_amdgcn_exp2f((float)(i + 1) * lg2);
    o0 *= gi1; o1 *= gi1;
#pragma unroll
    for (int j = 0; j < 4; ++j) if (j <= i) { const float cf = sdot[i * 4 + j] * __builtin_amdgcn_exp2f((float)(i - j) * lg2); o0 += cf * sv[j * 256 + dv2]; o1 += cf * sv[j * 256 + dv2 + 1]; }
    float s = o0 + o1;
#pragma unroll
    for (int o = 1; o < 64; o <<= 1) s += __shfl_xor(s, o);
    if (lane == 0) sred[wid] = s;
    __syncthreads();
    const float mean = (sred[2 * i] + sred[2 * i + 1]) * (1.0f / 256.0f);
    const float d0 = o0 - mean, d1 = o1 - mean;
    float q = d0 * d0 + d1 * d1;
#pragma unroll
    for (int o = 1; o < 64; o <<= 1) q += __shfl_xor(q, o);
    if (lane == 0) sred[8 + wid] = q;
    __syncthreads();
    const float var = (sred[8 + 2 * i] + sred[8 + 2 * i + 1]) * (1.0f / 256.0f);
    const float rstd = rsqrtf(var + 1e-5f);
    const size_t row = (size_t)(ROW_S + bs * 4 + i); const int cc = h * 256 + dv2;
    const unsigned zw = *(const unsigned*)(U + row * NIN + C_ZR + cc);
    const float y0 = (d0 * rstd * p.gn_g[cc] + p.gn_b[cc]) * siluf_(bf_lo(zw)), y1 = (d1 * rstd * p.gn_g[cc + 1] + p.gn_b[cc + 1]) * siluf_(bf_hi(zw));
    *(unsigned*)(Acat + row * KCAT + 1024 + cc) = cvt_pk_bf16(y0, y1);
    __syncthreads();
}

__device__ void phase3_scan(const Params& p) {
    const int gt = blockIdx.x * 512 + threadIdx.x;
    if (gt >= 131072) return;
    const int b = gt >> 16, h = (gt >> 13) & 7, rem = gt & 8191;
    const float* UcT = (const float*)(p.ws + OFF_UCT); const float* SmT = (const float*)(p.ws + OFF_SMT); bf16_t* SpT = (bf16_t*)(p.ws + OFF_SPT);
    const float g128 = __builtin_amdgcn_exp2f(128.0f * lg2_of(h));
    f32x4 S = *(const f32x4*)(SmT + (size_t)h * 32768 + rem * 4);
    const size_t off0 = ((size_t)(b * 32 * 8 + h)) * 32768 + rem * 4;
    f32x4 ua[8], ub[8];
#pragma unroll
    for (int k = 0; k < 8; ++k) ua[k] = *(const f32x4*)(UcT + off0 + (size_t)k * 262144);
#pragma unroll
    for (int k = 0; k < 8; ++k) ub[k] = *(const f32x4*)(UcT + off0 + (size_t)(8 + k) * 262144);
#pragma unroll
    for (int k = 0; k < 8; ++k) { u32x2 w; w.x = cvt_pk_bf16(S[0], S[1]); w.y = cvt_pk_bf16(S[2], S[3]); *(u32x2*)(SpT + off0 + (size_t)k * 262144) = w; S = g128 * S + ua[k]; }
#pragma unroll
    for (int k = 0; k < 8; ++k) ua[k] = *(const f32x4*)(UcT + off0 + (size_t)(16 + k) * 262144);
#pragma unroll
    for (int k = 0; k < 8; ++k) { u32x2 w; w.x = cvt_pk_bf16(S[0], S[1]); w.y = cvt_pk_bf16(S[2], S[3]); *(u32x2*)(SpT + off0 + (size_t)(8 + k) * 262144) = w; S = g128 * S + ub[k]; }
#pragma unroll
    for (int k = 0; k < 8; ++k) ub[k] = *(const f32x4*)(UcT + off0 + (size_t)(24 + k) * 262144);
#pragma unroll
    for (int k = 0; k < 8; ++k) { u32x2 w; w.x = cvt_pk_bf16(S[0], S[1]); w.y = cvt_pk_bf16(S[2], S[3]); *(u32x2*)(SpT + off0 + (size_t)(16 + k) * 262144) = w; S = g128 * S + ua[k]; }
#pragma unroll
    for (int k = 0; k < 8; ++k) { u32x2 w; w.x = cvt_pk_bf16(S[0], S[1]); w.y = cvt_pk_bf16(S[2], S[3]); *(u32x2*)(SpT + off0 + (size_t)(24 + k) * 262144) = w; S = g128 * S + ub[k]; }
    const int dv = rem >> 5, dk = (rem & 31) * 4;
    float* o = p.out + O_RP + ((size_t)(b * 8 + h) * 128 + dk) * 256 + dv;
    o[0] = S[0]; o[256] = S[1]; o[512] = S[2]; o[768] = S[3];
}

__device__ void ret_out_item(const Params& p, LAS unsigned char* lds, int item) {
    int tid_ = threadIdx.x; asm volatile("" : "+v"(tid_)); const int tid = tid_, lane = tid & 63, wid = __builtin_amdgcn_readfirstlane(tid >> 6), fr = lane & 15, fq = lane >> 4;
    const int h = item & 7, c = (item >> 3) & 31, b = item >> 8;
    const bf16_t* U = (const bf16_t*)(p.ws + OFF_U); const bf16_t* UT = (const bf16_t*)(p.ws + OFF_UT); bf16_t* Acat = (bf16_t*)(p.ws + OFF_ACAT);
    const bf16_t* SpT = (const bf16_t*)(p.ws + OFF_SPT) + (size_t)item * 32768;
    const float* cosR = (const float*)(p.ws + OFF_COSR); const float* sinR = (const float*)(p.ws + OFF_SINR);
    constexpr int TP = 136;
    LAS bf16_t* sK = (LAS bf16_t*)lds; LAS bf16_t* sX = sK + 128 * TP; LAS float* sGN = (LAS float*)(sX + 256 * TP);
    const int tokrow0 = b * 4096 + c * 128, pidx0 = 16 + c * 128;
    sGN[tid] = tid < 256 ? p.gn_g[h * 256 + tid] : p.gn_b[h * 256 + tid - 256];
    const float lg2 = lg2_of(h);
    bf16x8 qf[4];
    { const int i = wid * 16 + fr; const bf16_t* src = U + (size_t)(tokrow0 + i) * NIN + C_QR + h * 128 + fq * 8;
      float x[4][8];
#pragma unroll
      for (int ks = 0; ks < 4; ++ks) { const u32x4 w = *(const u32x4*)(src + ks * 32); unpack8(w, x[ks]); }
#pragma unroll
      for (int ks = 0; ks < 2; ++ks) { const float* cp = cosR + (size_t)(pidx0 + i) * 64 + ks * 32 + fq * 8; const float* sp = sinR + (size_t)(pidx0 + i) * 64 + ks * 32 + fq * 8;
          const f32x4 c0 = *(const f32x4*)cp, c1 = *(const f32x4*)(cp + 4), s0 = *(const f32x4*)sp, s1 = *(const f32x4*)(sp + 4);
#pragma unroll
          for (int e = 0; e < 8; ++e) { const float cs = e < 4 ? c0[e & 3] : c1[e & 3], sn = e < 4 ? s0[e & 3] : s1[e & 3]; const float x1 = x[ks][e], x2 = x[ks + 2][e];
              x[ks][e] = x1 * cs - x2 * sn; x[ks + 2][e] = x2 * cs + x1 * sn; } }
#pragma unroll
      for (int ks = 0; ks < 4; ++ks) qf[ks] = __builtin_bit_cast(bf16x8, pack8(x[ks])); }
#pragma unroll
    for (int q = 0; q < 2; ++q) { const int t = tid + q * 512; const int j = t >> 3, ch = t & 7;
        const bf16_t* src = U + (size_t)(tokrow0 + j) * NIN + C_KR + h * 128 + ch * 8;
        const u32x4 wa = *(const u32x4*)src, wb = *(const u32x4*)(src + 64);
        float a[8], bb[8], o1[8], o2[8]; unpack8(wa, a); unpack8(wb, bb);
        const float* cp = cosR + (size_t)(pidx0 + j) * 64 + ch * 8; const float* sp = sinR + (size_t)(pidx0 + j) * 64 + ch * 8;
        const f32x4 c0 = *(const f32x4*)cp, c1 = *(const f32x4*)(cp + 4), s0 = *(const f32x4*)sp, s1 = *(const f32x4*)(sp + 4);
#pragma unroll
        for (int e = 0; e < 8; ++e) { const float cs = e < 4 ? c0[e & 3] : c1[e & 3], sn = e < 4 ? s0[e & 3] : s1[e & 3];
            o1[e] = (a[e] * cs - bb[e] * sn) * 0.08838834764831845f; o2[e] = (bb[e] * cs + a[e] * sn) * 0.08838834764831845f; }
        *(LAS u32x4*)(sK + j * TP + ch * 8) = pack8(o1); *(LAS u32x4*)(sK + j * TP + 64 + ch * 8) = pack8(o2); }
    { u32x4 tmp[8];
#pragma unroll
      for (int q = 0; q < 8; ++q) { const int t = tid + q * 512; const int dv = t >> 4, ch = t & 15; tmp[q] = *(const u32x4*)(UT + (size_t)(UT_VR + h * 256 + dv) * UTP + tokrow0 + ch * 8); }
#pragma unroll
      for (int q = 0; q < 8; ++q) { const int t = tid + q * 512; const int dv = t >> 4, ch = t & 15; *(LAS u32x4*)(sX + dv * TP + ch * 8) = tmp[q]; } }
    __syncthreads();
    const int iq = wid * 16 + fr;
    bf16x8 pf[4];
#pragma unroll
    for (int k2 = 0; k2 < 4; ++k2) {
        u32x4 pw = (u32x4){0u, 0u, 0u, 0u};
        if (2 * k2 <= wid) {
            f32x4 s0 = (f32x4){0.f, 0.f, 0.f, 0.f}, s1 = (f32x4){0.f, 0.f, 0.f, 0.f};
#pragma unroll
            for (int ks = 0; ks < 4; ++ks) { const bf16x8 k0 = *(const LAS bf16x8*)(sK + (k2 * 32 + fr) * TP + ks * 32 + fq * 8), k1 = *(const LAS bf16x8*)(sK + (k2 * 32 + 16 + fr) * TP + ks * 32 + fq * 8);
                s0 = __builtin_amdgcn_mfma_f32_16x16x32_bf16(k0, qf[ks], s0, 0, 0, 0); s1 = __builtin_amdgcn_mfma_f32_16x16x32_bf16(k1, qf[ks], s1, 0, 0, 0); }
            float v[8];
#pragma unroll
            for (int r = 0; r < 4; ++r) { const int j0 = k2 * 32 + fq * 4 + r, j1 = j0 + 16;
                v[r] = j0 <= iq ? s0[r] * __builtin_amdgcn_exp2f(-(float)(j0 + 1) * lg2) : 0.f; v[4 + r] = j1 <= iq ? s1[r] * __builtin_amdgcn_exp2f(-(float)(j1 + 1) * lg2) : 0.f; }
            pw = pack8(v);
        }
        pf[k2] = __builtin_bit_cast(bf16x8, pw);
    }
    f32x4 o[16];
#pragma unroll
    for (int dt = 0; dt < 16; ++dt) { o[dt] = (f32x4){0.f, 0.f, 0.f, 0.f};
#pragma unroll
        for (int k2 = 0; k2 < 4; ++k2) if (2 * k2 <= wid) { const LAS bf16_t* vr = sX + (dt * 16 + fr) * TP + k2 * 32 + fq * 4;
            const u32x2 lo = *(const LAS u32x2*)vr, hi = *(const LAS u32x2*)(vr + 16); const u32x4 vw = (u32x4){lo.x, lo.y, hi.x, hi.y};
            o[dt] = __builtin_amdgcn_mfma_f32_16x16x32_bf16(__builtin_bit_cast(bf16x8, vw), pf[k2], o[dt], 0, 0, 0); } }
    { u32x4 tmp[8];
#pragma unroll
      for (int q = 0; q < 8; ++q) tmp[q] = *(const u32x4*)(SpT + (size_t)(tid + q * 512) * 8);
      __syncthreads();
#pragma unroll
      for (int q = 0; q < 8; ++q) { const int t = tid + q * 512; const int dv = t >> 4, ch = t & 15; *(LAS u32x4*)(sX + dv * TP + ch * 8) = tmp[q]; } }
    __syncthreads();
    const size_t row = (size_t)(tokrow0 + iq);
    u32x2 zr[16];
#pragma unroll
    for (int dt = 0; dt < 16; ++dt) zr[dt] = *(const u32x2*)(U + row * NIN + C_ZR + h * 256 + dt * 16 + fq * 4);
#pragma unroll
    for (int dt = 0; dt < 16; ++dt)
#pragma unroll
        for (int ks = 0; ks < 4; ++ks) { const bf16x8 sf = *(const LAS bf16x8*)(sX + (dt * 16 + fr) * TP + ks * 32 + fq * 8); o[dt] = __builtin_amdgcn_mfma_f32_16x16x32_bf16(sf, qf[ks], o[dt], 0, 0, 0); }
    const float gi1 = __builtin_amdgcn_exp2f((float)(iq + 1) * lg2);
    float sum = 0.f;
#pragma unroll
    for (int dt = 0; dt < 16; ++dt) { o[dt] *= gi1; sum += (o[dt][0] + o[dt][1]) + (o[dt][2] + o[dt][3]); }
    sum += __shfl_xor(sum, 16); sum += __shfl_xor(sum, 32);
    const float mean = sum * (1.0f / 256.0f);
    float q = 0.f;
#pragma unroll
    for (int dt = 0; dt < 16; ++dt) { o[dt] -= mean; q += (o[dt][0] * o[dt][0] + o[dt][1] * o[dt][1]) + (o[dt][2] * o[dt][2] + o[dt][3] * o[dt][3]); }
    q += __shfl_xor(q, 16); q += __shfl_xor(q, 32);
    const float rstd = rsqrtf(q * (1.0f / 256.0f) + 1e-5f);
#pragma unroll
    for (int dt = 0; dt < 16; ++dt) { const int cc = h * 256 + dt * 16 + fq * 4;
        const f32x4 gg = *(const LAS f32x4*)(sGN + dt * 16 + fq * 4), gb = *(const LAS f32x4*)(sGN + 256 + dt * 16 + fq * 4);
        const u32x2 zw = zr[dt];
        const float y0 = (o[dt][0] * rstd * gg[0] + gb[0]) * siluf_(bf_lo(zw.x)), y1 = (o[dt][1] * rstd * gg[1] + gb[1]) * siluf_(bf_hi(zw.x));
        const float y2 = (o[dt][2] * rstd * gg[2] + gb[2]) * siluf_(bf_lo(zw.y)), y3 = (o[dt][3] * rstd * gg[3] + gb[3]) * siluf_(bf_hi(zw.y));
        u32x2 w; w.x = cvt_pk_bf16(y0, y1); w.y = cvt_pk_bf16(y2, y3);
        *(u32x2*)(Acat + row * KCAT + 1024 + cc) = w; }
    __syncthreads();
}


#define XB_TMO      128
#define XB_XCNT(j)  (256  + 64 * (j))
#define XB_XSUB(j)  (1280 + 64 * (j))
#define XB_XGEN(j)  (2304 + 64 * (j))
#define XB_TOP      3328
#define XB_TOPGEN   3392
#define XCD_BAR_WORDS 3456
#define XB_SPIN_CAP (1u << 18)
__device__ __forceinline__ unsigned xb_ld(unsigned* p)              { return __hip_atomic_load(p, __ATOMIC_RELAXED, __HIP_MEMORY_SCOPE_AGENT); }
__device__ __forceinline__ unsigned xb_add(unsigned* p, unsigned v) { return __hip_atomic_fetch_add(p, v, __ATOMIC_RELAXED, __HIP_MEMORY_SCOPE_AGENT); }
__device__ __forceinline__ unsigned xb_xcc_id() { return (unsigned)__builtin_amdgcn_s_getreg((3 << 11) | 20) & 0xFu; }
#define XB_SPIN(cond, bar) do { unsigned _sp = 0; while (cond) { __builtin_amdgcn_s_sleep(1); \
    if ((++_sp & 255u) == 0u) { if (xb_ld(&(bar)[XB_TMO])) break; if (_sp > XB_SPIN_CAP) { atomicAdd(&(bar)[XB_TMO], 1u); break; } } } } while (0)
struct XcdBarrier { unsigned* bar; unsigned x; volatile LAS unsigned* st; };
__device__ __forceinline__ XcdBarrier xcd_barrier_post(unsigned* bar, volatile LAS unsigned* st) {
    XcdBarrier b; b.bar = bar; b.x = xb_xcc_id(); b.st = st;
    if (threadIdx.x == 0) (void)xb_add(&bar[XB_XCNT(b.x)], 1u);
    return b;
}
__device__ __forceinline__ void xcd_barrier_complete(unsigned* bar, unsigned x, unsigned& nloc, unsigned& nx) {
    const unsigned G = gridDim.x * gridDim.y * gridDim.z;
    unsigned sum, cnt, mine, sp = 0u;
    for (;;) {
        sum = 0u; cnt = 0u; mine = 0u;
#pragma unroll
        for (unsigned j = 0; j < 16; ++j) { const unsigned c = xb_ld(&bar[XB_XCNT(j)]); sum += c; cnt += (c > 0u) ? 1u : 0u; mine = (j == x) ? c : mine; }
        if (sum == G) break;
        __builtin_amdgcn_s_sleep(1);
        if ((++sp & 255u) == 0u) { if (xb_ld(&bar[XB_TMO])) break; if (sp > XB_SPIN_CAP) { atomicAdd(&bar[XB_TMO], 1u); break; } }
    }
    nloc = mine > 0u ? mine : 1u; nx = cnt > 0u ? cnt : 1u;
}
__device__ __forceinline__ void xcd_barrier(const XcdBarrier& b) {
    asm volatile("s_waitcnt vmcnt(0)" ::: "memory");
    __syncthreads();
    if (threadIdx.x == 0) {
        unsigned* bar = b.bar;
        __builtin_amdgcn_s_waitcnt(0);
        unsigned nloc = b.st[0], nx = b.st[1];
        if (nloc == 0u) { xcd_barrier_complete(bar, b.x, nloc, nx); b.st[0] = nloc; b.st[1] = nx; }
        const unsigned old = xb_add(&bar[XB_XSUB(b.x)], 1u);
        const unsigned gen = old / nloc;
        if (old + 1u == (gen + 1u) * nloc) {
            __builtin_amdgcn_fence(__ATOMIC_RELEASE, "agent");
            asm volatile("s_waitcnt vmcnt(0)" ::: "memory");
            const unsigned og = xb_add(&bar[XB_TOP], 1u);
            const unsigned tg = og / nx;
            if (og + 1u == (tg + 1u) * nx) xb_add(&bar[XB_TOPGEN], 1u);
            else XB_SPIN(xb_ld(&bar[XB_TOPGEN]) == tg, bar);
            __builtin_amdgcn_fence(__ATOMIC_ACQUIRE, "agent");
            xb_add(&bar[XB_XGEN(b.x)], 1u);
            asm volatile("s_waitcnt vmcnt(0)" ::: "memory");
        } else {
            XB_SPIN(xb_ld(&bar[XB_XGEN(b.x)]) == gen, bar);
            __builtin_amdgcn_fence(__ATOMIC_ACQUIRE, "agent");
            asm volatile("s_waitcnt vmcnt(0)" ::: "memory");
        }
    }
    __syncthreads();
}

__global__ void __launch_bounds__(512, 2) mega(Params p) {
    extern __shared__ __attribute__((aligned(16))) unsigned char shm[];
    LAS unsigned char* lds = (LAS unsigned char*)shm;
    cg::grid_group grid = cg::this_grid();
    const int bid = blockIdx.x, nb = gridDim.x;
    unsigned char* ws = p.ws;
    volatile LAS unsigned* xst = (volatile LAS unsigned*)(lds + LDS_BYTES - 16);
    if (threadIdx.x == 0) { xst[0] = 0u; xst[1] = 0u; }
    __syncthreads();
    const XcdBarrier xb = xcd_barrier_post((unsigned*)(ws + OFF_BAR), xst);
    if (p.ph_hi > 1000) grid.sync();
#define PH(n) ((n) >= p.ph_lo && (n) < p.ph_hi)
#define SEAM(n) do { if ((n) + 1 > p.ph_lo && (n) + 1 < p.ph_hi) xcd_barrier(xb); } while (0)
#define REPS(n) for (int rep_ = 0; rep_ <= ((REP >> (n)) & 1); ++rep_)
#define RSYNC do { if (rep_) xcd_barrier(xb); } while (0)
    if (PH(0)) REPS(0) { RSYNC; phase0(p, lds); }
    SEAM(0);
    if (PH(1)) REPS(1) { RSYNC; pg8::Gemm g{(const bf16_t*)(ws + OFF_XN), (const bf16_t*)(ws + OFF_WINT), MROWS, NIN, DM}; pg8::StaticOrder S; S.init(g.M, g.N, nb, bid);
        EpiU E{(bf16_t*)(ws + OFF_U), (bf16_t*)(ws + OFF_UT)}; pg8::gemm_phase<EpiU>(lds, g, S, E); }
    SEAM(1);
    if (PH(2)) REPS(2) { RSYNC;
        const int n_my = (2312 - bid + nb - 1) / nb;
        for (int k = 0; k < n_my; ++k) { const int it = bid + nb * ((bid & 1) ? n_my - 1 - k : k);
            if (it < 256) attn_prompt_item(p, lds, it);
            else if (it < 776) ret_chunk_item(p, lds, it - 256);
            else if (it < 1288) attn_sample_item(p, lds, it - 776);
            else ret_sample_item(p, lds, it - 1288);
        }
    }
    SEAM(2);
    if (PH(3)) REPS(3) { RSYNC; phase3_scan(p); }
    SEAM(3);
    if (PH(4)) REPS(4) { RSYNC; for (int it = bid; it < 512; it += nb) ret_out_item(p, lds, it); }
    SEAM(4);
    if (PH(5)) REPS(5) { RSYNC; pg8::Gemm g{(const bf16_t*)(ws + OFF_ACAT), (const bf16_t*)(ws + OFF_WCAT), MR2, DM, KCAT}; pg8::StaticOrder S; S.init(g.M, g.N, nb, bid);
        EpiMrg E{(const bf16_t*)(ws + OFF_U), (bf16_t*)(ws + OFF_MRG)}; pg8::gemm_phase<EpiMrg>(lds, g, S, E); }
    SEAM(5);
    if (PH(6)) REPS(6) { RSYNC; pg8::Gemm g{(const bf16_t*)(ws + OFF_MRG), (const bf16_t*)(ws + OFF_WO), MR2, DM, DM}; pg8::StaticOrder S; S.init(g.M, g.N, nb, bid);
        EpiOut E{p.x_prompt, p.x_sample, p.out + O_YP, p.out + O_YS}; pg8::gemm_phase<EpiOut>(lds, g, S, E); }
    if (REP & 256) { for (int i = 0; i < 10; ++i) xcd_barrier(xb); }
#undef REPS
#undef RSYNC
#undef PH
#undef SEAM
}

extern "C" void kernel_launch(void* const* d_in, const int* in_sizes, int n_in, void* d_out, int out_size, void* d_ws, size_t ws_size, hipStream_t stream) {
    static int grid = 0;
    if (grid == 0) {
        if (n_in != 16 || ws_size < WS_END2) { fprintf(stderr, "kernel_launch: unexpected n_in %d / ws %zu (need %zu)\n", n_in, ws_size, (size_t)WS_END2); grid = -1; return; }
        int dev = 0, cus = 0, per_cu = 0;
        hipGetDevice(&dev); hipDeviceGetAttribute(&cus, hipDeviceAttributeMultiprocessorCount, dev);
        if (hipFuncSetAttribute((const void*)mega, hipFuncAttributeMaxDynamicSharedMemorySize, LDS_BYTES) != hipSuccess) { fprintf(stderr, "kernel_launch: hipFuncSetAttribute failed\n"); grid = -1; return; }
        if (hipOccupancyMaxActiveBlocksPerMultiprocessor(&per_cu, (const void*)mega, 512, LDS_BYTES) != hipSuccess || per_cu < 1) { fprintf(stderr, "kernel_launch: occupancy query says %d\n", per_cu); per_cu = 1; (void)hipGetLastError(); }
        grid = cus;
    }
    if (grid < 0) return;
    Params p{};
    p.x_prompt = (const float*)d_in[0]; p.x_sample = (const float*)d_in[1]; p.cache_k = (const float*)d_in[2]; p.cache_v = (const float*)d_in[3]; p.state = (const float*)d_in[4];
    p.meta = (const float*)d_in[5]; p.norm_g = (const float*)d_in[6]; p.w_in = (const float*)d_in[7]; p.q_g = (const float*)d_in[8]; p.k_g = (const float*)d_in[9]; p.sinks = (const float*)d_in[10];
    p.gn_g = (const float*)d_in[11]; p.gn_b = (const float*)d_in[12]; p.w_pa = (const float*)d_in[13]; p.w_pr = (const float*)d_in[14]; p.w_o = (const float*)d_in[15];
    p.out = (float*)d_out; p.ws = (unsigned char*)d_ws; p.ph_lo = 0; p.ph_hi = 7;
    if (hipMemsetAsync((unsigned char*)d_ws + OFF_BAR, 0, 3456 * 4, stream) != hipSuccess) { fprintf(stderr, "kernel_launch: memset of barrier words failed\n"); return; }
    void* args[] = {&p};
    hipError_t e = hipLaunchCooperativeKernel((const void*)mega, dim3(grid), dim3(512), args, LDS_BYTES, stream);
    if (e != hipSuccess) fprintf(stderr, "cooperative launch failed: %s (grid %d)\n", hipGetErrorString(e), grid);
}
```
